# Optimizing an MI355X kernel written in HIP

```python
import jax, jax.numpy as jnp
from jax import lax
import numpy as np

D_MODEL = 2048
BATCH = 8
SEQ = 2048
DEPTH = 1

HEAD_DIM_A = 64
N_Q_A = 16
N_KV_A = 4
WINDOW = 128
HEAD_DIM_B = 128
N_H_B = 8
MOBA_BLOCK = 256
MOBA_TOPK = 3
MOBA_Q_CHUNK = 16
D_FF = ((-((-8 * D_MODEL) // 3) + 255) // 256) * 256
RMS_EPS = 1e-6

WQ_A = N_Q_A * HEAD_DIM_A
WKV_A = N_KV_A * HEAD_DIM_A
W_B = N_H_B * HEAD_DIM_B
IN_COLS = WQ_A + 2 * WKV_A + 3 * W_B + 2 * D_MODEL

kernel_name = "hybrid_gated_swa_sink_moba_swiglu"


def rms_norm(x, g):
    xf = x.astype(jnp.float32)
    y = xf * lax.rsqrt(jnp.mean(xf * xf, axis=-1, keepdims=True) + RMS_EPS)
    return (y * g.astype(jnp.float32)).astype(x.dtype)


def alibi_slopes(n):
    return jnp.exp2(-8.0 * jnp.arange(1, n + 1, dtype=jnp.float32) / n)


def sliding_window_sink_attention(q, k, v, sinks, slopes):
    B, S, Hq, dh = q.shape
    Hkv = k.shape[2]
    R = Hq // Hkv
    L = WINDOW
    nb = S // L
    qb = (q * (dh ** -0.5)).reshape(B, nb, L, Hkv, R, dh)
    kb = k.reshape(B, nb, L, Hkv, dh)
    vb = v.reshape(B, nb, L, Hkv, dh)
    pad = ((0, 0), (1, 0), (0, 0), (0, 0), (0, 0))
    kwin = jnp.concatenate([jnp.pad(kb, pad)[:, :-1], kb], axis=2)
    vwin = jnp.concatenate([jnp.pad(vb, pad)[:, :-1], vb], axis=2)
    s = jnp.einsum('bnqgrd,bnkgd->bgrnqk', qb, kwin).astype(jnp.float32)
    qi = jnp.arange(L)[:, None]
    kj = jnp.arange(2 * L)[None, :]
    dist = L + qi - kj
    kpos = (jnp.arange(nb)[:, None, None] - 1) * L + kj[None]
    valid = (dist >= 0) & (dist < WINDOW) & (kpos >= 0)
    s = s - slopes.reshape(Hkv, R, 1, 1, 1) * dist.astype(jnp.float32)
    s = jnp.where(valid, s, -jnp.inf)
    sink = sinks.astype(jnp.float32).reshape(Hkv, R, 1, 1, 1)
    m = jnp.maximum(s.max(axis=-1, keepdims=True), sink)
    e = jnp.exp(s - m)
    p = e / (e.sum(axis=-1, keepdims=True) + jnp.exp(sink - m))
    o = jnp.einsum('bgrnqk,bnkgd->bnqgrd', p.astype(v.dtype), vwin)
    return o.reshape(B, S, Hq * dh)


def moba_attention(q, k, v, slopes):
    B, S, H, dh = q.shape
    nblk = -(-S // MOBA_BLOCK)
    Sp = nblk * MOBA_BLOCK
    padw = ((0, 0), (0, Sp - S), (0, 0), (0, 0))
    qh = jnp.pad(q * (dh ** -0.5), padw).transpose(0, 2, 1, 3)
    kh = jnp.pad(k, padw).transpose(0, 2, 1, 3)
    vh = jnp.pad(v, padw).transpose(0, 2, 1, 3)
    kblk = kh.reshape(B, H, nblk, MOBA_BLOCK, dh)
    vblk = vh.reshape(B, H, nblk, MOBA_BLOCK, dh)
    kmean = kblk.astype(jnp.float32).mean(axis=3)
    gate = jnp.einsum('bhsd,bhnd->bhsn', qh.astype(jnp.float32), kmean)
    cur = jnp.arange(Sp) // MOBA_BLOCK
    past = jnp.arange(nblk)[None, :] < cur[:, None]
    gate = jnp.where(past, gate, -jnp.inf)
    n_sel = min(MOBA_TOPK, nblk)
    _, sel = lax.top_k(gate, n_sel)
    sel_valid = sel < cur[:, None]
    bi = jnp.arange(B)[:, None, None, None]
    hi = jnp.arange(H)[None, :, None, None]
    slope_g = slopes[None, :, None, None, None]
    slope_o = slopes[None, :, None, None]
    offs = jnp.arange(MOBA_BLOCK)
    n_keys_sel = n_sel * MOBA_BLOCK

    def chunk(c):
        start = c * MOBA_Q_CHUNK
        qc = lax.dynamic_slice_in_dim(qh, start, MOBA_Q_CHUNK, axis=2)
        selc = lax.dynamic_slice_in_dim(sel, start, MOBA_Q_CHUNK, axis=2)
        valc = lax.dynamic_slice_in_dim(sel_valid, start, MOBA_Q_CHUNK, axis=2)
        own0 = (start // MOBA_BLOCK) * MOBA_BLOCK
        k_own = lax.dynamic_slice_in_dim(kh, own0, MOBA_BLOCK, axis=2)
        v_own = lax.dynamic_slice_in_dim(vh, own0, MOBA_BLOCK, axis=2)
        k_sel = kblk[bi, hi, selc]
        v_sel = vblk[bi, hi, selc]
        tq = start + jnp.arange(MOBA_Q_CHUNK)
        d_sel = (tq[:, None, None] - (selc[..., None] * MOBA_BLOCK + offs)).astype(jnp.float32)
        s_sel = jnp.einsum('bhqd,bhqjkd->bhqjk', qc, k_sel).astype(jnp.float32) - slope_g * d_sel
        s_sel = jnp.where(valc[..., None], s_sel, -jnp.inf)
        d_own = tq[:, None] - (own0 + offs)[None, :]
        s_own = jnp.einsum('bhqd,bhkd->bhqk', qc, k_own).astype(jnp.float32) - slope_o * d_own.astype(jnp.float32)
        s_own = jnp.where(d_own >= 0, s_own, -jnp.inf)
        logits = jnp.concatenate([s_sel.reshape(B, H, MOBA_Q_CHUNK, n_keys_sel), s_own], axis=-1)
        p = jax.nn.softmax(logits, axis=-1).astype(v.dtype)
        p_sel = p[..., :n_keys_sel].reshape(B, H, MOBA_Q_CHUNK, n_sel, MOBA_BLOCK)
        p_own = p[..., n_keys_sel:]
        return (jnp.einsum('bhqjk,bhqjkd->bhqd', p_sel, v_sel)
                + jnp.einsum('bhqk,bhkd->bhqd', p_own, v_own))

    o = lax.map(chunk, jnp.arange(Sp // MOBA_Q_CHUNK))
    o = o.transpose(1, 0, 3, 2, 4).reshape(B, Sp, H * dh)
    return o[:, :S]


def setup_inputs(seed: int = 0) -> dict:
    key = jax.random.key(seed)
    ks = jax.random.split(key, 16)
    f = jnp.float32

    def nrm(k, shape, scale):
        return jax.random.normal(k, shape, f) * scale

    return {
        "x": nrm(ks[0], (BATCH, SEQ, D_MODEL), 1.0),
        "norm1_g": 1.0 + nrm(ks[1], (DEPTH, D_MODEL), 0.02),
        "w_in": nrm(ks[2], (DEPTH, D_MODEL, IN_COLS), D_MODEL ** -0.5),
        "b_gate": nrm(ks[3], (DEPTH, 2 * D_MODEL), 0.02),
        "q_norm_a": 1.0 + nrm(ks[4], (DEPTH, HEAD_DIM_A), 0.02),
        "k_norm_a": 1.0 + nrm(ks[5], (DEPTH, HEAD_DIM_A), 0.02),
        "sinks_a": nrm(ks[6], (DEPTH, N_Q_A), 0.5),
        "q_norm_b": 1.0 + nrm(ks[7], (DEPTH, HEAD_DIM_B), 0.02),
        "k_norm_b": 1.0 + nrm(ks[8], (DEPTH, HEAD_DIM_B), 0.02),
        "w_branch_a": nrm(ks[9], (DEPTH, WQ_A, D_MODEL), WQ_A ** -0.5),
        "w_branch_b": nrm(ks[10], (DEPTH, W_B, D_MODEL), W_B ** -0.5),
        "w_o": nrm(ks[11], (DEPTH, D_MODEL, D_MODEL), D_MODEL ** -0.5),
        "norm2_g": 1.0 + nrm(ks[12], (DEPTH, D_MODEL), 0.02),
        "w_ffn_gate": nrm(ks[13], (DEPTH, D_MODEL, D_FF), D_MODEL ** -0.5),
        "w_ffn_up": nrm(ks[14], (DEPTH, D_MODEL, D_FF), D_MODEL ** -0.5),
        "w_ffn_down": nrm(ks[15], (DEPTH, D_FF, D_MODEL), D_FF ** -0.5),
    }


def reference(x, norm1_g, w_in, b_gate, q_norm_a, k_norm_a, sinks_a, q_norm_b, k_norm_b,
              w_branch_a, w_branch_b, w_o, norm2_g, w_ffn_gate, w_ffn_up, w_ffn_down):
    B, S, _ = x.shape
    slopes_a = alibi_slopes(N_Q_A)
    slopes_b = alibi_slopes(N_H_B)
    cuts = np.cumsum([WQ_A, WKV_A, WKV_A, W_B, W_B, W_B, D_MODEL]).tolist()
    h = x
    for l in range(DEPTH):
        u = rms_norm(h, norm1_g[l])
        z = u @ w_in[l]
        qa, ka, va, qb, kb, vb, ga, gb = jnp.split(z, cuts, axis=-1)
        qa = rms_norm(qa.reshape(B, S, N_Q_A, HEAD_DIM_A), q_norm_a[l])
        ka = rms_norm(ka.reshape(B, S, N_KV_A, HEAD_DIM_A), k_norm_a[l])
        va = va.reshape(B, S, N_KV_A, HEAD_DIM_A)
        o_a = sliding_window_sink_attention(qa, ka, va, sinks_a[l], slopes_a)
        qb = rms_norm(qb.reshape(B, S, N_H_B, HEAD_DIM_B), q_norm_b[l])
        kb = rms_norm(kb.reshape(B, S, N_H_B, HEAD_DIM_B), k_norm_b[l])
        vb = vb.reshape(B, S, N_H_B, HEAD_DIM_B)
        o_b = moba_attention(qb, kb, vb, slopes_b)
        gate_a = jax.nn.sigmoid(ga.astype(jnp.float32) + b_gate[l, :D_MODEL]).astype(h.dtype)
        gate_b = jax.nn.sigmoid(gb.astype(jnp.float32) + b_gate[l, D_MODEL:]).astype(h.dtype)
        mixed = gate_a * (o_a @ w_branch_a[l]) + gate_b * (o_b @ w_branch_b[l])
        h = h + mixed @ w_o[l]
        u2 = rms_norm(h, norm2_g[l])
        h = h + (jax.nn.silu(u2 @ w_ffn_gate[l]) * (u2 @ w_ffn_up[l])) @ w_ffn_down[l]
    return h
```

```cpp
#include <hip/hip_runtime.h>
#include <stdint.h>
#include <type_traits>
#include <cstdio>

typedef unsigned short bf16_t;
typedef short bf16x8 __attribute__((ext_vector_type(8)));
typedef float f32x4 __attribute__((ext_vector_type(4)));
typedef unsigned u32x4 __attribute__((ext_vector_type(4)));
typedef unsigned u32x2 __attribute__((ext_vector_type(2)));

constexpr int BATCH = 8, SEQ = 2048, DM = 2048, M = BATCH * SEQ;
constexpr int NIN = 8704, DFF = 5632;
constexpr int C_QA = 0, C_KA = 1024, C_VA = 1280, C_QB = 1536, C_KB = 2560, C_VB = 3584, C_G = 4608;
constexpr float RMS_EPS = 1e-6f;
constexpr float LOG2E = 1.4426950408889634f;
constexpr float SC_QA = 0.125f * LOG2E, SC_QB = 0.08838834764831845f * LOG2E;
constexpr int NWAVES = 8, NTHREADS = 512;

constexpr size_t MiB = 1u << 20;
constexpr size_t WS_CTL = 0;
constexpr size_t WS_SUMSQ = 1 * MiB;
constexpr size_t WS_KMEAN = 1 * MiB + 128 * 1024;
constexpr size_t WS_WIN = 2 * MiB;
constexpr size_t WS_WAB = 36 * MiB;
constexpr size_t WS_WO = 44 * MiB;
constexpr size_t WS_WGU = 52 * MiB;
constexpr size_t WS_WD = 96 * MiB;
constexpr size_t WS_XN = 118 * MiB;
constexpr size_t WS_QA = 182 * MiB;
constexpr size_t WS_KA = 214 * MiB;
constexpr size_t WS_VA = 222 * MiB;
constexpr size_t WS_QB = 230 * MiB;
constexpr size_t WS_KB = 262 * MiB;
constexpr size_t WS_VB = 294 * MiB;
constexpr size_t WS_GATES = 326 * MiB;
constexpr size_t WS_MIXED = WS_GATES;
constexpr size_t WS_ACT = 182 * MiB;
constexpr int    ACT_GAP_FROM = 52;
constexpr size_t ACT_GAP = (454 - 182) * MiB - (size_t)ACT_GAP_FROM * 256 * 5632 * 2;
constexpr size_t WS_END = 487 * MiB;

struct Params {
    const float *x, *norm1_g, *w_in, *b_gate, *qna, *kna, *sinks, *qnb, *knb, *wba, *wbb, *wo, *norm2_g, *wg, *wu, *wd;
    float* out; unsigned char* ws;
};

__device__ __forceinline__ int opaque_tid() { int t = threadIdx.x; asm volatile("" : "+v"(t)); return t; }
__device__ __forceinline__ unsigned f2bf(float f) { unsigned u = __builtin_bit_cast(unsigned, f); return (u + 0x7fffu + ((u >> 16) & 1u)) >> 16; }
__device__ __forceinline__ unsigned pk2(float lo, float hi) { return f2bf(lo) | (f2bf(hi) << 16); }
__device__ __forceinline__ float bf2f(unsigned short b) { return __builtin_bit_cast(float, (unsigned)b << 16); }
__device__ __forceinline__ float bflo(unsigned w) { return __builtin_bit_cast(float, w << 16); }
__device__ __forceinline__ float bfhi(unsigned w) { return __builtin_bit_cast(float, w & 0xffff0000u); }
__device__ __forceinline__ float wave_sum(float v) {
#pragma unroll
    for (int o = 1; o < 64; o <<= 1) v += __shfl_xor(v, o);
    return v;
}
__device__ __forceinline__ float wave_max(float v) {
#pragma unroll
    for (int o = 1; o < 64; o <<= 1) v = fmaxf(v, __shfl_xor(v, o));
    return v;
}

typedef float f32x2_t __attribute__((ext_vector_type(2))); typedef __bf16 bf16x2_t __attribute__((ext_vector_type(2)));
__device__ __forceinline__ unsigned cvt2(float lo, float hi) { f32x2_t v = {lo, hi}; bf16x2_t b = __builtin_convertvector(v, bf16x2_t); return __builtin_bit_cast(unsigned, b); }
#define P0_LAS __attribute__((address_space(3)))
__device__ __forceinline__ int p0_drow(int n, int mapk) {
    if (mapk == 0) return n;
    if (mapk == 3 || (mapk == 4 && n < C_G)) return (n & ~255) + 128 * ((n >> 5) & 1) + 32 * ((n >> 6) & 3) + (n & 31);
    if (mapk == 4) { const int g = (n >= C_G + 2048) ? 1 : 0, c = n - C_G - 2048 * g; return C_G + 256 * (c >> 7) + 128 * g + (c & 127); }
    return 256 * (n >> 7) + (n & 127) + (mapk == 2 ? 128 : 0);
}
struct WItem { const float* src; const float* ks; bf16_t* d; int ldw, ldd, n0, mapk; };
__device__ __forceinline__ WItem p0_mk(const float* W, int ldw, int n0, int k0, const float* kscale, bf16_t* dst, int ldd, int dstk0, int mapk, int lane) {
    const int l = lane & 31, h = lane >> 5;
    WItem it; it.src = W + (size_t)(k0 + 16 * h) * ldw + n0 + 4 * l; it.ks = kscale ? kscale + k0 + 16 * h : nullptr;
    it.d = dst + dstk0 + k0 + 8 * (lane & 7); it.ldw = ldw; it.ldd = ldd; it.n0 = n0; it.mapk = mapk; return it;
}
__device__ __forceinline__ void p0_ld(const WItem& it, int b, f32x4 (&v)[16]) {
#pragma unroll
    for (int i = 0; i < 16; ++i) v[i] = __builtin_nontemporal_load((const f32x4*)(it.src + (size_t)(32 * b + i) * it.ldw));
}
__device__ __forceinline__ void p0_tolds(const WItem& it, int b, f32x4 (&v)[16], P0_LAS unsigned char* buf, int lane) {
    if (it.ks) {
#pragma unroll
        for (int i = 0; i < 16; ++i) v[i] = v[i] * it.ks[32 * b + i];
    }
    const int l = lane & 31, h = lane >> 5;
#pragma unroll
    for (int e = 0; e < 4; ++e)
#pragma unroll
        for (int q = 0; q < 2; ++q) {
            u32x4 o; o.x = cvt2(v[8 * q + 0][e], v[8 * q + 1][e]); o.y = cvt2(v[8 * q + 2][e], v[8 * q + 3][e]); o.z = cvt2(v[8 * q + 4][e], v[8 * q + 5][e]); o.w = cvt2(v[8 * q + 6][e], v[8 * q + 7][e]);
            const int c = 4 * b + 2 * h + q;
            *(P0_LAS u32x4*)(buf + (4 * l + e) * 128 + ((c ^ (l & 7)) << 4)) = o;
        }
}
__device__ __forceinline__ void p0_flush(const WItem& it, P0_LAS unsigned char* buf, int lane) {
#pragma unroll
    for (int j = 0; j < 16; ++j) {
        const int r = 8 * j + (lane >> 3), c = lane & 7;
        const u32x4 o = *(const P0_LAS u32x4*)(buf + r * 128 + ((c ^ ((r >> 2) & 7)) << 4));
        *(u32x4*)(it.d + (size_t)p0_drow(it.n0 + r, it.mapk) * it.ldd) = o;
    }
}
template <int SET> __device__ __forceinline__ int p0_count() { return SET == 0 ? 68 * 32 + 2 * 44 * 32 : SET == 1 ? 2 * 16 * 16 + 16 * 32 : 16 * 88; }
template <int SET> __device__ __forceinline__ WItem p0_decode(const Params& p, int r, int lane) {
    unsigned char* ws = p.ws;
    if (SET == 0) {
        constexpr int I_G = 44 * 32;
        if (r < I_G) return p0_mk(p.wg, DFF, 128 * (r >> 5), 64 * (r & 31), p.norm2_g, (bf16_t*)(ws + WS_WGU), 2048, 0, 1, lane);
        r -= I_G;
        if (r < I_G) return p0_mk(p.wu, DFF, 128 * (r >> 5), 64 * (r & 31), p.norm2_g, (bf16_t*)(ws + WS_WGU), 2048, 0, 2, lane);
        r -= I_G;
        return p0_mk(p.w_in, NIN, 128 * (r >> 5), 64 * (r & 31), nullptr, (bf16_t*)(ws + WS_WIN), 2048, 0, 4, lane);
    } else if (SET == 1) {
        constexpr int I_BA = 16 * 16;
        if (r < I_BA) return p0_mk(p.wba, 2048, 128 * (r >> 4), 64 * (r & 15), nullptr, (bf16_t*)(ws + WS_WAB), 2048, 0, 3, lane);
        r -= I_BA;
        if (r < I_BA) return p0_mk(p.wbb, 2048, 128 * (r >> 4), 64 * (r & 15), nullptr, (bf16_t*)(ws + WS_WAB), 2048, 1024, 3, lane);
        r -= I_BA;
        return p0_mk(p.wo, 2048, 128 * (r >> 5), 64 * (r & 31), nullptr, (bf16_t*)(ws + WS_WO), 2048, 0, 3, lane);
    } else {
        return p0_mk(p.wd, 2048, 128 * (r / 88), 64 * (r % 88), nullptr, (bf16_t*)(ws + WS_WD), DFF, 0, 3, lane);
    }
}
template <int SET>
__device__ __forceinline__ void p0_weights(const Params& p, int gw, int NGW, P0_LAS unsigned char* lds) {
    const int tid = opaque_tid(), lane = tid & 63; const int cnt = p0_count<SET>();
    if (gw >= cnt) return;
    P0_LAS unsigned char* buf = lds + (tid >> 6) * 16384;
    f32x4 va[16], vb[16];
    WItem cur = p0_decode<SET>(p, gw, lane);
    p0_ld(cur, 0, va);
    for (int it = gw; it < cnt; it += NGW) {
        p0_ld(cur, 1, vb);
        p0_tolds(cur, 0, va, buf, lane);
        const bool more = it + NGW < cnt;
        WItem nxt = cur;
        if (more) { nxt = p0_decode<SET>(p, it + NGW, lane); p0_ld(nxt, 0, va); }
        p0_tolds(cur, 1, vb, buf, lane);
        p0_flush(cur, buf, lane);
        cur = nxt;
    }
}

__device__ __forceinline__ void p0_prologue(const Params& p, bool defer_late, int bid, int nblk, P0_LAS unsigned char* lds) {
    const int tid = opaque_tid(), lane = tid & 63, wave = tid >> 6;
    const int gw = bid * NWAVES + wave, NGW = nblk * NWAVES;
    unsigned char* ws = p.ws;
    float* z = (float*)(ws + WS_SUMSQ);
    for (int i = bid * NTHREADS + tid; i < 16384; i += nblk * NTHREADS) z[i] = 0.f;
    int* z2 = (int*)(ws + WS_KMEAN);
    for (int i = bid * NTHREADS + tid; i < 65536; i += nblk * NTHREADS) z2[i] = 0;
    if (!defer_late) { p0_weights<2>(p, gw, NGW, lds); p0_weights<1>(p, gw, NGW, lds); }
    p0_weights<0>(p, gw, NGW, lds);
    bf16_t* XN = (bf16_t*)(ws + WS_XN);
    if (gw < M) {
        f32x4 v[8], w[8];
        { const f32x4* xr = (const f32x4*)(p.x + (size_t)gw * DM) + lane;
#pragma unroll
          for (int j = 0; j < 8; ++j) v[j] = __builtin_nontemporal_load(xr + 64 * j); }
        for (int m = gw; m < M; m += NGW) {
            const bool more = m + NGW < M;
            if (more) { const f32x4* xr = (const f32x4*)(p.x + (size_t)(m + NGW) * DM) + lane;
#pragma unroll
                for (int j = 0; j < 8; ++j) w[j] = __builtin_nontemporal_load(xr + 64 * j); }
            float s = 0.f;
#pragma unroll
            for (int j = 0; j < 8; ++j) s += (v[j].x * v[j].x + v[j].y * v[j].y) + (v[j].z * v[j].z + v[j].w * v[j].w);
            const float rstd = rsqrtf(wave_sum(s) * (1.f / DM) + RMS_EPS);
            u32x2* o8 = (u32x2*)(XN + (size_t)m * DM) + lane;
#pragma unroll
            for (int j = 0; j < 8; ++j) { const f32x4 g = ((const f32x4*)p.norm1_g)[64 * j + lane];
                u32x2 o; o.x = cvt2(v[j].x * rstd * g.x, v[j].y * rstd * g.y); o.y = cvt2(v[j].z * rstd * g.z, v[j].w * rstd * g.w);
                o8[64 * j] = o; }
#pragma unroll
            for (int j = 0; j < 8; ++j) v[j] = w[j];
        }
    }
}

__device__ __forceinline__ void unpack8(const u32x4 w, float (&f)[8]) {
    f[0] = bflo(w.x); f[1] = bfhi(w.x); f[2] = bflo(w.y); f[3] = bfhi(w.y); f[4] = bflo(w.z); f[5] = bfhi(w.z); f[6] = bflo(w.w); f[7] = bfhi(w.w);
}
namespace pg8 {
#define PG8_LAS __attribute__((address_space(3)))
constexpr int BM = 256, BK = 64, HALF = 128, HTB = HALF * BK * 2, STAGE_BYTES = 8 * HTB, NXCD = 8, WGM = 8;
__host__ __device__ __forceinline__ int lds_byte(int r, int c) { const int st = (r >> 4) * 2 + (c >> 5), rr = r & 15, cc = c & 31, ob = rr * 64 + cc * 2; return st * 1024 + (ob ^ (((ob >> 9) & 1) << 5)); }
__host__ __device__ __forceinline__ void stage_rc(int b, int& R, int& C) { const int st = b / 1024, sb = b % 1024, swz = sb ^ (((sb >> 9) & 1) << 5); R = (st >> 1) * 16 + swz / 64; C = (st & 1) * 32 + (swz % 64) / 2; }
__host__ __device__ __forceinline__ int perm32(int rho) { const int n = rho >> 4, i = rho & 15; return 8 * (i >> 2) + 4 * n + (i & 3); }

struct Unit { int pm, pn, pass; };
struct Gemm { const bf16_t* A; const bf16_t* Bt; int lda, ldb, nt, kpass; unsigned gapA; int gapFrom; };

template <int NPASS> struct TileOrder {
    int nM, nN, nwg, G, c;
    __device__ void init(int M_, int N_, int G_, int c_) { nM = M_ / BM; nN = N_ / BM; nwg = nM * nN; G = G_; c = c_; }
    __device__ bool next(int i, Unit& u) const {
        const int ti = i / NPASS; u.pass = i % NPASS;
        const long L = (long)ti * G + c; if (L >= nwg) return false;
        int wgid = (int)L; { const int q = nwg / NXCD, r = nwg % NXCD, xcd = wgid % NXCD, off = wgid / NXCD; wgid = (xcd < r ? xcd * (q + 1) : r * (q + 1) + (xcd - r) * q) + off; }
        const int nig = WGM * nN, gid = wgid / nig, fm = gid * WGM, gsz = (nM - fm) < WGM ? (nM - fm) : WGM;
        u.pm = fm + ((wgid % nig) % gsz); u.pn = (wgid % nig) / gsz;
        u.pn = (u.pn + 4 * (int)(L % NXCD)) % nN;
        return true;
    }
};

__device__ __forceinline__ unsigned cvt_pk_bf16(float lo, float hi) { f32x2_t v = {lo, hi}; bf16x2_t b = __builtin_convertvector(v, bf16x2_t); return __builtin_bit_cast(unsigned, b); }
__device__ __forceinline__ u32x4 pack8(const f32x4 v0, const f32x4 v1) { u32x4 w; w.x = cvt_pk_bf16(v0[0], v0[1]); w.y = cvt_pk_bf16(v0[2], v0[3]); w.z = cvt_pk_bf16(v1[0], v1[1]); w.w = cvt_pk_bf16(v1[2], v1[3]); return w; }
__device__ __forceinline__ float fast_sigmoid(float x) { return __builtin_amdgcn_rcpf(1.0f + __builtin_amdgcn_exp2f(-1.4426950408889634f * x)); }

struct EpiZ {
    static constexpr bool PERM = true;
    struct Pre {}; __device__ __forceinline__ Pre prefetch(const Unit&, int, int, int, int) const { return Pre{}; }
    unsigned char* ws; const float* b_gate; const float* qna; const float* kna; const float* knb; PG8_LAS float* xch;
    __device__ __forceinline__ bool operator()(f32x4 (&acc)[2][2][4][2], const Unit& u, int wr, int wc, int fr, int fq, const Pre&) const {
        const int colt = u.pn * BM, row0 = u.pm * BM + wr * 64 + fr;
        if (colt >= C_KB && colt < C_VB) {
            float ssr[2][4];
#pragma unroll
            for (int ai = 0; ai < 2; ++ai)
#pragma unroll
                for (int m = 0; m < 4; ++m) { float ss = 0.f;
#pragma unroll
                    for (int bj = 0; bj < 2; ++bj)
#pragma unroll
                        for (int n = 0; n < 2; ++n) { const f32x4 v = acc[ai][bj][m][n]; ss += (v[0] * v[0] + v[1] * v[1]) + (v[2] * v[2] + v[3] * v[3]); }
                    ss += __shfl_xor(ss, 16); ss += __shfl_xor(ss, 32); ssr[ai][m] = ss;
                    if (fq == 0) xch[(wr * 4 + wc) * 128 + (ai * 4 + m) * 16 + fr] = ss; }
            asm volatile("s_waitcnt lgkmcnt(0)" ::: "memory"); __builtin_amdgcn_s_barrier(); asm volatile("" ::: "memory");
            const int d0 = 64 * (wc & 1) + 8 * fq;
            f32x4 gv[2][2];
#pragma unroll
            for (int bj = 0; bj < 2; ++bj)
#pragma unroll
                for (int n = 0; n < 2; ++n) gv[bj][n] = *(const f32x4*)(knb + d0 + 32 * bj + 4 * n);
            f32x4 cs[2][2];
#pragma unroll
            for (int bj = 0; bj < 2; ++bj)
#pragma unroll
                for (int n = 0; n < 2; ++n) cs[bj][n] = (f32x4){0.f, 0.f, 0.f, 0.f};
            bf16_t* base = (bf16_t*)(ws + WS_KB); const int col0 = (colt - C_KB) + wc * 64 + 8 * fq;
#pragma unroll
            for (int ai = 0; ai < 2; ++ai)
#pragma unroll
                for (int m = 0; m < 4; ++m) {
                    const float tot = ssr[ai][m] + xch[(wr * 4 + (wc ^ 1)) * 128 + (ai * 4 + m) * 16 + fr];
                    const float rs = rsqrtf(tot * (1.f / 128.f) + RMS_EPS);
                    bf16_t* rowp = base + (size_t)(row0 + ai * HALF + m * 16) * 1024 + col0;
#pragma unroll
                    for (int bj = 0; bj < 2; ++bj) { const f32x4 y0 = acc[ai][bj][m][0] * rs * gv[bj][0], y1 = acc[ai][bj][m][1] * rs * gv[bj][1];
                        cs[bj][0] += y0; cs[bj][1] += y1;
                        *(u32x4*)(rowp + bj * 32) = pack8(y0, y1); } }
            int* km = (int*)(ws + WS_KMEAN) + (size_t)u.pm * 1024 + col0;
#pragma unroll
            for (int bj = 0; bj < 2; ++bj)
#pragma unroll
                for (int n = 0; n < 2; ++n)
#pragma unroll
                    for (int e = 0; e < 4; ++e) { float v = cs[bj][n][e];
                        v += __shfl_xor(v, 1); v += __shfl_xor(v, 2); v += __shfl_xor(v, 4); v += __shfl_xor(v, 8);
                        if (fr == 0) atomicAdd(km + 32 * bj + 4 * n + e, __float2int_rn(v * 262144.f)); }
            return false;
        }
        bf16_t* base; int ldc, cl;
        if (colt < C_KA) { base = (bf16_t*)(ws + WS_QA); ldc = 1024; cl = colt - C_QA; }
        else if (colt < C_VA) { base = (bf16_t*)(ws + WS_KA); ldc = 256; cl = colt - C_KA; }
        else if (colt < C_QB) { base = (bf16_t*)(ws + WS_VA); ldc = 256; cl = colt - C_VA; }
        else if (colt < C_KB) { base = (bf16_t*)(ws + WS_QB); ldc = 1024; cl = colt - C_QB; }
        else if (colt < C_VB) { base = (bf16_t*)(ws + WS_KB); ldc = 1024; cl = colt - C_KB; }
        else if (colt < C_G) { base = (bf16_t*)(ws + WS_VB); ldc = 1024; cl = colt - C_VB; }
        else { base = (bf16_t*)(ws + WS_GATES); ldc = 4096; cl = colt - C_G; }
        const int col0 = cl + wc * 64 + 8 * fq;
        if (colt < C_VA) {
            const float* g = (colt < C_KA) ? qna : kna; const float sc = (colt < C_KA) ? SC_QA : 1.0f;
            f32x4 gv[2][2];
#pragma unroll
            for (int bj = 0; bj < 2; ++bj)
#pragma unroll
                for (int n = 0; n < 2; ++n) gv[bj][n] = *(const f32x4*)(g + 32 * bj + 8 * fq + 4 * n) * sc;
#pragma unroll
            for (int ai = 0; ai < 2; ++ai)
#pragma unroll
                for (int m = 0; m < 4; ++m) { bf16_t* rowp = base + (size_t)(row0 + ai * HALF + m * 16) * ldc + col0;
                    float ss = 0.f;
#pragma unroll
                    for (int bj = 0; bj < 2; ++bj)
#pragma unroll
                        for (int n = 0; n < 2; ++n) { const f32x4 v = acc[ai][bj][m][n]; ss += (v[0] * v[0] + v[1] * v[1]) + (v[2] * v[2] + v[3] * v[3]); }
                    ss += __shfl_xor(ss, 16); ss += __shfl_xor(ss, 32);
                    const float rs = rsqrtf(ss * (1.f / 64.f) + RMS_EPS);
#pragma unroll
                    for (int bj = 0; bj < 2; ++bj) *(u32x4*)(rowp + bj * 32) = pack8(acc[ai][bj][m][0] * rs * gv[bj][0], acc[ai][bj][m][1] * rs * gv[bj][1]); }
        } else if (colt < C_G) {
#pragma unroll
            for (int ai = 0; ai < 2; ++ai)
#pragma unroll
                for (int m = 0; m < 4; ++m) { bf16_t* rowp = base + (size_t)(row0 + ai * HALF + m * 16) * ldc + col0;
#pragma unroll
                    for (int bj = 0; bj < 2; ++bj) *(u32x4*)(rowp + bj * 32) = pack8(acc[ai][bj][m][0], acc[ai][bj][m][1]); }
        } else {
            const int mc0 = ((colt - C_G) >> 1) + wc * 32 + 8 * fq;
            f32x4 ba[2], bb[2];
#pragma unroll
            for (int n = 0; n < 2; ++n) { ba[n] = *(const f32x4*)(b_gate + mc0 + 4 * n); bb[n] = *(const f32x4*)(b_gate + 2048 + mc0 + 4 * n); }
#pragma unroll
            for (int ai = 0; ai < 2; ++ai)
#pragma unroll
                for (int m = 0; m < 4; ++m) { bf16_t* rowp = (bf16_t*)(ws + WS_GATES) + (size_t)(row0 + ai * HALF + m * 16) * 4096 + mc0;
                    f32x4 r0, r1, g0, g1;
#pragma unroll
                    for (int e = 0; e < 4; ++e) {
                        const float ea0 = __builtin_amdgcn_exp2f(-1.4426950408889634f * (acc[ai][0][m][0][e] + ba[0][e])), ea1 = __builtin_amdgcn_exp2f(-1.4426950408889634f * (acc[ai][0][m][1][e] + ba[1][e]));
                        const float eb0 = __builtin_amdgcn_exp2f(-1.4426950408889634f * (acc[ai][1][m][0][e] + bb[0][e])), eb1 = __builtin_amdgcn_exp2f(-1.4426950408889634f * (acc[ai][1][m][1][e] + bb[1][e]));
                        g0[e] = __builtin_amdgcn_rcpf(1.0f + eb0); g1[e] = __builtin_amdgcn_rcpf(1.0f + eb1);
                        r0[e] = (1.0f + eb0) * __builtin_amdgcn_rcpf(1.0f + ea0); r1[e] = (1.0f + eb1) * __builtin_amdgcn_rcpf(1.0f + ea1);
                    }
                    *(u32x4*)(rowp) = pack8(r0, r1); *(u32x4*)(rowp + 2048) = pack8(g0, g1); }
        }
        return false;
    }
};
struct EpiMixed {
    static constexpr bool PERM = true;
    struct Pre {}; __device__ __forceinline__ Pre prefetch(const Unit&, int, int, int, int) const { return Pre{}; }
    const bf16_t* G; bf16_t* MX;
    __device__ __forceinline__ bool operator()(f32x4 (&acc)[2][2][4][2], const Unit& u, int wr, int wc, int fr, int fq, const Pre&) const {
        const int row0 = u.pm * BM + wr * 64 + fr, col0 = u.pn * BM + wc * 64 + 8 * fq;
#pragma unroll
        for (int ai = 0; ai < 2; ++ai)
#pragma unroll
            for (int m = 0; m < 4; ++m) { const size_t row = (size_t)(row0 + ai * HALF + m * 16);
#pragma unroll
                for (int bj = 0; bj < 2; ++bj) { const int col = col0 + bj * 32;
                    const u32x4 gw = *(const u32x4*)(G + row * 4096 + (u.pass == 0 ? 0 : 2048) + col);
                    float gg[8]; unpack8(gw, gg);
                    if (u.pass == 0) {
#pragma unroll
                        for (int e = 0; e < 4; ++e) { acc[ai][bj][m][0][e] *= gg[e]; acc[ai][bj][m][1][e] *= gg[4 + e]; }
                    } else {
                        f32x4 v0, v1;
#pragma unroll
                        for (int e = 0; e < 4; ++e) { v0[e] = acc[ai][bj][m][0][e] * gg[e]; v1[e] = acc[ai][bj][m][1][e] * gg[4 + e]; }
                        *(u32x4*)(MX + row * 4096 + col) = pack8(v0, v1);
                    } } }
        return u.pass == 0;
    }
};
struct EpiWo {
    static constexpr bool PERM = true;
    struct Pre {}; __device__ __forceinline__ Pre prefetch(const Unit&, int, int, int, int) const { return Pre{}; }
    const float* x; float* out; bf16_t* H1B; float* sumsq;
    __device__ __forceinline__ bool operator()(f32x4 (&acc)[2][2][4][2], const Unit& u, int wr, int wc, int fr, int fq, const Pre&) const {
        const int row0 = u.pm * BM + wr * 64 + fr, col0 = u.pn * BM + wc * 64 + 8 * fq;
#pragma unroll
        for (int ai = 0; ai < 2; ++ai)
#pragma unroll
            for (int m = 0; m < 4; ++m) { const int row = row0 + ai * HALF + m * 16; const size_t off = (size_t)row * DM + col0; float ss = 0.f;
#pragma unroll
                for (int bj = 0; bj < 2; ++bj) { const size_t o = off + bj * 32;
                    const f32x4 h0 = *(const f32x4*)(x + o) + acc[ai][bj][m][0], h1 = *(const f32x4*)(x + o + 4) + acc[ai][bj][m][1];
                    *(u32x4*)(H1B + o) = pack8(h0, h1);
                    ss += ((h0[0] * h0[0] + h0[1] * h0[1]) + (h0[2] * h0[2] + h0[3] * h0[3])) + ((h1[0] * h1[0] + h1[1] * h1[1]) + (h1[2] * h1[2] + h1[3] * h1[3])); }
                ss += __shfl_xor(ss, 16); ss += __shfl_xor(ss, 32);
                if (fq == 0) atomicAdd(sumsq + row, ss);
                if (m & 1) asm volatile("" ::: "memory"); }
        return false;
    }
};
struct EpiSwiglu {
    static constexpr bool PERM = true;
    const float* sumsq; bf16_t* ACT;
    struct Pre { float ss[2][4]; };
    __device__ __forceinline__ Pre prefetch(const Unit& u, int wr, int wc, int fr, int fq) const { Pre r; const int row0 = u.pm * BM + wr * 64 + fr;
#pragma unroll
        for (int ai = 0; ai < 2; ++ai)
#pragma unroll
            for (int m = 0; m < 4; ++m) r.ss[ai][m] = sumsq[row0 + ai * HALF + m * 16];
        return r; }
    __device__ __forceinline__ bool operator()(f32x4 (&acc)[2][2][4][2], const Unit& u, int wr, int wc, int fr, int fq, const Pre& pre) const {
        const int row0 = u.pm * BM + wr * 64 + fr, acol0 = u.pn * HALF + wc * 32 + 8 * fq;
#pragma unroll
        for (int ai = 0; ai < 2; ++ai)
#pragma unroll
            for (int m = 0; m < 4; ++m) { const int row = row0 + ai * HALF + m * 16;
                const float rstd = rsqrtf(pre.ss[ai][m] * (1.f / DM) + RMS_EPS);
                f32x4 a0, a1;
#pragma unroll
                for (int e = 0; e < 4; ++e) { const float g0 = acc[ai][0][m][0][e] * rstd, g1 = acc[ai][0][m][1][e] * rstd;
                    a0[e] = g0 * fast_sigmoid(g0) * (acc[ai][1][m][0][e] * rstd); a1[e] = g1 * fast_sigmoid(g1) * (acc[ai][1][m][1][e] * rstd); }
                *(u32x4*)(ACT + (size_t)row * DFF + acol0 + (u.pm >= ACT_GAP_FROM ? ACT_GAP / 2 : (size_t)0)) = pack8(a0, a1); }
        return false;
    }
};
struct EpiDown {
    static constexpr bool PERM = true;
    struct Pre {}; __device__ __forceinline__ Pre prefetch(const Unit&, int, int, int, int) const { return Pre{}; }
    float* out; const bf16_t* H1B;
    __device__ __forceinline__ bool operator()(f32x4 (&acc)[2][2][4][2], const Unit& u, int wr, int wc, int fr, int fq, const Pre&) const {
        const int row0 = u.pm * BM + wr * 64 + fr, col0 = u.pn * BM + wc * 64 + 8 * fq;
#pragma unroll
        for (int ai = 0; ai < 2; ++ai)
#pragma unroll
            for (int m = 0; m < 4; ++m) { const size_t off = (size_t)(row0 + ai * HALF + m * 16) * DM + col0;
#pragma unroll
                for (int bj = 0; bj < 2; ++bj) { const size_t o = off + bj * 32; const u32x4 w = *(const u32x4*)(H1B + o);
                    *(f32x4*)(out + o) = (f32x4){bflo(w.x), bfhi(w.x), bflo(w.y), bfhi(w.y)} + acc[ai][bj][m][0];
                    *(f32x4*)(out + o + 4) = (f32x4){bflo(w.z), bfhi(w.z), bflo(w.w), bfhi(w.w)} + acc[ai][bj][m][1]; }
                if (m & 1) asm volatile("" ::: "memory"); }
        return false;
    }
};

template <class Epi, class Sched>
__device__ __forceinline__ void gemm_phase(PG8_LAS unsigned char* lds, const Gemm g, const Sched& S, const Epi& E) {
    const int tid = opaque_tid(), wid = __builtin_amdgcn_readfirstlane(tid >> 6), lane = tid & 63, wr = wid >> 2, wc = wid & 3, fr = lane & 15, fq = lane >> 4;
    const int nt = g.nt;
    unsigned voffA[2], voffB[2];
#pragma unroll
    for (int i = 0; i < 2; ++i) { int R, C; stage_rc(tid * 16 + i * 8192, R, C); const int Rb = Epi::PERM ? ((R & ~31) + perm32(R & 31)) : R;
        voffA[i] = (unsigned)(R * g.lda + C) * 2u; voffB[i] = (unsigned)(Rb * g.ldb + C) * 2u; }
    const unsigned kstep = (unsigned)(BK * 2);
    const unsigned hstepA = (unsigned)HALF * g.lda * 2, hstepB = (unsigned)HALF * g.ldb * 2;
    const unsigned tstepA = 2 * hstepA, tstepB = 2 * hstepB;
    const __amdgpu_buffer_rsrc_t rsA = __builtin_amdgcn_make_buffer_rsrc((void*)g.A, 0, -1, 0x00020000);
    const __amdgpu_buffer_rsrc_t rsB = __builtin_amdgcn_make_buffer_rsrc((void*)g.Bt, 0, -1, 0x00020000);
    const unsigned ldsw = (unsigned)wid * 1024u;
    const int aoff = lds_byte(wr * 64 + fr, fq * 8), boff = lds_byte(wc * 32 + fr, fq * 8);
#define PG8_SA(b, h) (((b) * 2 + (h)) * HTB)
#define PG8_SB(b, h) ((4 + (b) * 2 + (h)) * HTB)
#define PG8_STAGE(bufoff, rs, soff, voff) do { _Pragma("unroll") for (int _i = 0; _i < 2; ++_i) \
        __builtin_amdgcn_raw_ptr_buffer_load_lds(rs, (PG8_LAS unsigned*)(lds + (bufoff) + ldsw + _i * 8192), 16, (int)(voff)[_i], (int)(soff), 0, 0); } while (0)
#define PG8_LDA(dst, b, h) do { _Pragma("unroll") for (int m = 0; m < 4; ++m) _Pragma("unroll") for (int k = 0; k < 2; ++k) dst[m][k] = *(const PG8_LAS bf16x8*)(lds + PG8_SA(b, h) + aoff + m * 2048 + k * 1024); } while (0)
#define PG8_LDB(dst, b, h) do { _Pragma("unroll") for (int n = 0; n < 2; ++n) _Pragma("unroll") for (int k = 0; k < 2; ++k) dst[n][k] = *(const PG8_LAS bf16x8*)(lds + PG8_SB(b, h) + boff + n * 2048 + k * 1024); } while (0)
#define PG8_MMA(ai, bj, At, Bt) do { __builtin_amdgcn_s_setprio(1); _Pragma("unroll") for (int m = 0; m < 4; ++m) _Pragma("unroll") for (int n = 0; n < 2; ++n) _Pragma("unroll") for (int k = 0; k < 2; ++k) \
        acc[ai][bj][m][n] = __builtin_amdgcn_mfma_f32_16x16x32_bf16(Bt[n][k], At[m][k], acc[ai][bj][m][n], 0, 0, 0); __builtin_amdgcn_s_setprio(0); } while (0)
#define PG8_WAIT_V(n) asm volatile("s_waitcnt vmcnt(" #n ")" ::: "memory")
#define PG8_WAIT_L(n) asm volatile("s_waitcnt lgkmcnt(" #n ")" ::: "memory")
#define PG8_BAR __builtin_amdgcn_s_barrier()
#define PG8_SCHED __builtin_amdgcn_sched_barrier(0)
    Unit cur, nxt; int ui = 0;
    if (!S.next(0, cur)) return;
    f32x4 acc[2][2][4][2];
#pragma unroll
    for (int a = 0; a < 2; ++a)
#pragma unroll
        for (int b = 0; b < 2; ++b)
#pragma unroll
            for (int m = 0; m < 4; ++m)
#pragma unroll
                for (int n = 0; n < 2; ++n) acc[a][b][m][n] = (f32x4){0.f, 0.f, 0.f, 0.f};
    bf16x8 At[4][2], B0[2][2], B1[2][2];
    typename Epi::Pre pre = E.prefetch(cur, wr, wc, fr, fq);
    unsigned cA = (unsigned)cur.pm * tstepA + (unsigned)cur.pass * g.kpass * 2 + (cur.pm >= g.gapFrom ? g.gapA : 0u), cB = (unsigned)cur.pn * tstepB + (unsigned)cur.pass * g.kpass * 2;
    PG8_STAGE(PG8_SB(0, 0), rsB, cB, voffB); PG8_STAGE(PG8_SB(0, 1), rsB, cB + hstepB, voffB); PG8_STAGE(PG8_SA(0, 0), rsA, cA, voffA); PG8_STAGE(PG8_SA(0, 1), rsA, cA + hstepA, voffA);
    if (wr == 1) PG8_BAR;
    PG8_WAIT_V(2); PG8_BAR;
    PG8_STAGE(PG8_SB(1, 0), rsB, cB + kstep, voffB); PG8_STAGE(PG8_SA(1, 0), rsA, cA + kstep, voffA); PG8_STAGE(PG8_SB(1, 1), rsB, cB + hstepB + kstep, voffB);
    PG8_WAIT_V(6); PG8_BAR;
    for (;;) {
        const bool has_next = S.next(ui + 1, nxt);
        const unsigned nA = has_next ? (unsigned)nxt.pm * tstepA + (unsigned)nxt.pass * g.kpass * 2 + (nxt.pm >= g.gapFrom ? g.gapA : 0u) : cA;
        const unsigned nB = has_next ? (unsigned)nxt.pn * tstepB + (unsigned)nxt.pass * g.kpass * 2 : cB;
        for (int t = 0; t < nt; t += 2) {
            const bool last = (t == nt - 2);
            const unsigned a1 = cA + (unsigned)(t + 1) * kstep;
            const unsigned a2 = last ? nA : cA + (unsigned)(t + 2) * kstep, b2 = last ? nB : cB + (unsigned)(t + 2) * kstep;
            const unsigned a3 = a2 + kstep, b3 = b2 + kstep;
            PG8_LDB(B0, 0, 0); PG8_LDB(B1, 0, 1); PG8_SCHED; PG8_LDA(At, 0, 0); PG8_STAGE(PG8_SA(1, 1), rsA, a1 + hstepA, voffA);
            PG8_WAIT_V(8); PG8_WAIT_L(0); PG8_BAR; PG8_MMA(0, 0, At, B0); PG8_MMA(0, 1, At, B1); PG8_BAR; PG8_SCHED;
            PG8_LDA(At, 0, 1); PG8_STAGE(PG8_SB(0, 0), rsB, b2, voffB); PG8_STAGE(PG8_SB(0, 1), rsB, b2 + hstepB, voffB); PG8_STAGE(PG8_SA(0, 0), rsA, a2, voffA);
            PG8_WAIT_V(8); PG8_WAIT_L(0); PG8_BAR; PG8_MMA(1, 0, At, B0); PG8_MMA(1, 1, At, B1); PG8_BAR; PG8_SCHED;
            PG8_LDB(B0, 1, 0); PG8_LDB(B1, 1, 1); PG8_SCHED; PG8_LDA(At, 1, 0); PG8_STAGE(PG8_SA(0, 1), rsA, a2 + hstepA, voffA);
            PG8_WAIT_V(8); PG8_WAIT_L(0); PG8_BAR; PG8_MMA(0, 0, At, B0); PG8_MMA(0, 1, At, B1); PG8_BAR; PG8_SCHED;
            PG8_LDA(At, 1, 1); PG8_STAGE(PG8_SB(1, 0), rsB, b3, voffB); PG8_STAGE(PG8_SB(1, 1), rsB, b3 + hstepB, voffB); PG8_STAGE(PG8_SA(1, 0), rsA, a3, voffA);
            PG8_WAIT_V(8); PG8_WAIT_L(0); PG8_BAR; PG8_MMA(1, 0, At, B0); PG8_MMA(1, 1, At, B1); PG8_BAR; PG8_SCHED;
        }
        if (wr == 0) PG8_BAR;
        const bool keep = E(acc, cur, wr, wc, fr, fq, pre);
        if (has_next) pre = E.prefetch(nxt, wr, wc, fr, fq);
        if (!has_next) break;
        if (!keep) {
#pragma unroll
            for (int a = 0; a < 2; ++a)
#pragma unroll
                for (int b = 0; b < 2; ++b)
#pragma unroll
                    for (int m = 0; m < 4; ++m)
#pragma unroll
                        for (int n = 0; n < 2; ++n) acc[a][b][m][n] = (f32x4){0.f, 0.f, 0.f, 0.f};
        }
        cur = nxt; cA = nA; cB = nB; ++ui;
        if (wr == 1) PG8_BAR;
    }
    PG8_WAIT_V(0);
    PG8_BAR;
#undef PG8_SA
#undef PG8_SB
#undef PG8_STAGE
#undef PG8_LDA
#undef PG8_LDB
#undef PG8_MMA
#undef PG8_WAIT_V
#undef PG8_WAIT_L
#undef PG8_BAR
#undef PG8_SCHED
}
}

namespace att {
#define ATT_LAS __attribute__((address_space(3)))
typedef float f32x16 __attribute__((ext_vector_type(16)));
typedef short s16x4 __attribute__((ext_vector_type(4)));
constexpr float NEG = -1.0e30f;
constexpr float SHIFT = 12.0f;
template <int D> struct Cfg {
    static constexpr int KP = D * 2 + 16;
    static constexpr int VP = (D == 128) ? 320 : 192;
    static constexpr int KBYTES = 64 * KP, VBYTES = 64 * VP, STG = KBYTES + VBYTES;
    static constexpr int NKS = D / 16, NDB = D / 32, NCH = D / 8, PPT = (64 * NCH) / NTHREADS;
};
__device__ __forceinline__ s16x4 vtr(const ATT_LAS unsigned char* p) { return __builtin_bit_cast(s16x4, __builtin_amdgcn_ds_read_tr16_b64_v4i16((ATT_LAS s16x4*)p)); }

template <int D, bool MOBA>
__device__ __forceinline__ void attn_unit(ATT_LAS unsigned char* lds, const Params& p, int b, int hg, int blk) {
    typedef Cfg<D> C;
    const int tid = opaque_tid(), lane = tid & 63, wave = __builtin_amdgcn_readfirstlane(tid >> 6), q = lane & 31, hi = lane >> 5;
    unsigned char* ws = p.ws;
    const int seqbase = b * SEQ;
    const int qpos0 = MOBA ? 256 * blk : 64 * blk;
    const int t = MOBA ? qpos0 + 32 * wave + q : qpos0 + 32 * (wave & 1) + q;
    const int head = MOBA ? hg : 4 * hg + (wave >> 1);
    const size_t row = (size_t)(seqbase + t);
    const bf16_t* Qrow = MOBA ? (const bf16_t*)(ws + WS_QB) + row * 1024 + head * 128 : (const bf16_t*)(ws + WS_QA) + row * 1024 + head * 64;
    const int kvpitch = MOBA ? 1024 : 256;
    const bf16_t* Kp = (MOBA ? (const bf16_t*)(ws + WS_KB) : (const bf16_t*)(ws + WS_KA)) + (size_t)seqbase * kvpitch + hg * D;
    const bf16_t* Vp = (MOBA ? (const bf16_t*)(ws + WS_VB) : (const bf16_t*)(ws + WS_VA)) + (size_t)seqbase * kvpitch + hg * D;
    bf16_t* Orow = (bf16_t*)(ws + WS_XN) + row * 2048 + (MOBA ? 1024 + head * 128 : head * 64);
    const float slope2 = (MOBA ? exp2f(-(float)(head + 1)) : exp2f(-0.5f * (float)(head + 1))) * LOG2E;

    bf16x8 qf[C::NKS];
#pragma unroll
    for (int ks = 0; ks < C::NKS; ++ks) qf[ks] = *(const bf16x8*)(Qrow + 16 * ks + 8 * hi);

    if constexpr (MOBA) {
        float ssq = 0.f;
#pragma unroll
        for (int ks = 0; ks < C::NKS; ++ks) { float f[8]; unpack8(__builtin_bit_cast(u32x4, qf[ks]), f);
#pragma unroll
            for (int j = 0; j < 8; ++j) ssq += f[j] * f[j]; }
        ssq += __shfl_xor(ssq, 32);
        const float rs = rsqrtf(ssq * (1.f / 128.f) + RMS_EPS) * SC_QB;
#pragma unroll
        for (int ks = 0; ks < C::NKS; ++ks) { float f[8]; unpack8(__builtin_bit_cast(u32x4, qf[ks]), f);
            const f32x4 g0 = *(const f32x4*)(p.qnb + 16 * ks + 8 * hi), g1 = *(const f32x4*)(p.qnb + 16 * ks + 8 * hi + 4);
            u32x4 w; w.x = pg8::cvt_pk_bf16(f[0] * rs * g0[0], f[1] * rs * g0[1]); w.y = pg8::cvt_pk_bf16(f[2] * rs * g0[2], f[3] * rs * g0[3]);
            w.z = pg8::cvt_pk_bf16(f[4] * rs * g1[0], f[5] * rs * g1[1]); w.w = pg8::cvt_pk_bf16(f[6] * rs * g1[2], f[7] * rs * g1[3]);
            qf[ks] = __builtin_bit_cast(bf16x8, w); }
    }
    unsigned selbits = 0u;
    if constexpr (MOBA) {
        if (blk > 0) {
            const int* kmean = (const int*)(ws + WS_KMEAN) + (size_t)(b * 8) * 1024 + head * 128 + 8 * hi;
            float gt[8];
#pragma unroll
            for (int n = 0; n < 7; ++n) {
                float g = -INFINITY;
                if (n < blk) {
                    float part = 0.f;
#pragma unroll
                    for (int ks = 0; ks < 8; ++ks) {
                        const int4 k0 = *(const int4*)(kmean + n * 1024 + 16 * ks), k1 = *(const int4*)(kmean + n * 1024 + 16 * ks + 4);
                        const u32x4 qw = __builtin_bit_cast(u32x4, qf[ks]);
                        part += bflo(qw.x) * (float)k0.x + bfhi(qw.x) * (float)k0.y + bflo(qw.y) * (float)k0.z + bfhi(qw.y) * (float)k0.w
                              + bflo(qw.z) * (float)k1.x + bfhi(qw.z) * (float)k1.y + bflo(qw.w) * (float)k1.z + bfhi(qw.w) * (float)k1.w;
                    }
                    g = part + __shfl_xor(part, 32);
                }
                gt[n] = g;
            }
            gt[7] = -INFINITY;
#pragma unroll
            for (int n = 0; n < 7; ++n) {
                int rank = 0;
#pragma unroll
                for (int n2 = 0; n2 < 7; ++n2) if (n2 != n) rank += (n2 < blk && (gt[n2] > gt[n] || (gt[n2] == gt[n] && n2 < n))) ? 1 : 0;
                if (n < blk && rank < 3) selbits |= (1u << n);
            }
        }
    }

    f32x16 O[C::NDB];
#pragma unroll
    for (int db = 0; db < C::NDB; ++db)
#pragma unroll
        for (int r = 0; r < 16; ++r) O[db][r] = 0.f;
    float l = 0.f;

    const int T = MOBA ? 4 * (blk + 1) : (blk >= 2 ? 3 : blk + 1);
#define ATT_KPOS(i) (MOBA ? ((i) < 4 ? 256 * blk + 64 * (i) : 256 * (((i) - 4) >> 2) + 64 * (((i) - 4) & 3)) : qpos0 - 64 * (i))
    u32x4 kreg[C::PPT], vreg[C::PPT];
    const int prow = tid / C::NCH, pch = tid % C::NCH;
    const unsigned goff = (unsigned)(prow * kvpitch + pch * 8) * 2u;
    const int lk = C::KP * prow + 16 * pch, lv = C::KBYTES + C::VP * prow + 16 * pch;
    constexpr int PR = NTHREADS / C::NCH;
#define ATT_LOAD(kp0) do { const char* _kt = (const char*)(Kp + (size_t)(kp0) * kvpitch); const char* _vt = (const char*)(Vp + (size_t)(kp0) * kvpitch); \
        _Pragma("unroll") for (int _i = 0; _i < C::PPT; ++_i) { kreg[_i] = *(const u32x4*)(_kt + (size_t)_i * PR * kvpitch * 2 + goff); vreg[_i] = *(const u32x4*)(_vt + (size_t)_i * PR * kvpitch * 2 + goff); } } while (0)
#define ATT_WRITE(buf) do { _Pragma("unroll") for (int _i = 0; _i < C::PPT; ++_i) { \
        *(ATT_LAS u32x4*)(lds + (buf) * C::STG + lk + _i * PR * C::KP) = kreg[_i]; *(ATT_LAS u32x4*)(lds + (buf) * C::STG + lv + _i * PR * C::VP) = vreg[_i]; } } while (0)
    const int ka = C::KP * q + 16 * hi;
    const int va = C::VP * (4 * hi + ((lane & 15) >> 2)) + 32 * ((lane >> 4) & 1) + 8 * (lane & 3);
    ATT_LOAD(ATT_KPOS(0)); ATT_WRITE(0); if (T > 1) ATT_LOAD(ATT_KPOS(1)); __syncthreads();
    const int TA = MOBA ? 0 : T;
    for (int i = 0; i < TA; ++i) {
        if (i + 1 < T) ATT_WRITE((i + 1) & 1);
        if (i + 2 < T) ATT_LOAD(ATT_KPOS(i + 2));
        const int kp0 = ATT_KPOS(i);
        int klo = 0, khi = 63;
        if constexpr (MOBA) { khi = t - kp0; }
        else { if (i == 0) khi = t - kp0; if (i == 2) klo = t - 127 - kp0; }
        if (khi > 63) khi = 63; if (klo < 0) klo = 0;
        const bool anyvalid = (khi >= klo);
        if (__any(anyvalid)) {
            const float lbase = slope2 * (float)(kp0 + 4 * hi - t) - SHIFT;
#pragma unroll 1
            for (int hf = 0; hf < 2; ++hf) {
                if (!__any(anyvalid && klo <= 32 * hf + 31 && khi >= 32 * hf)) continue;
                const bool allfull = __all(!anyvalid || (klo <= 32 * hf && khi >= 32 * hf + 31));
                const ATT_LAS unsigned char* Kt = lds + (i & 1) * C::STG + hf * 32 * C::KP;
                const ATT_LAS unsigned char* Vt = lds + (i & 1) * C::STG + C::KBYTES + hf * 32 * C::VP;
                const float lb = anyvalid ? lbase + (float)(32 * hf) * slope2 : NEG;
                f32x16 s;
                if (allfull) {
#pragma unroll
                    for (int r = 0; r < 16; ++r) s[r] = __builtin_fmaf(slope2, (float)((r & 3) + 8 * (r >> 2)), lb);
                } else {
#pragma unroll
                    for (int r = 0; r < 16; ++r) { const int ko = 32 * hf + 4 * hi + (r & 3) + 8 * (r >> 2);
                        s[r] = (ko >= klo && ko <= khi) ? __builtin_fmaf(slope2, (float)((r & 3) + 8 * (r >> 2)), lb) : NEG; }
                }
#pragma unroll
                for (int ks = 0; ks < C::NKS; ++ks) s = __builtin_amdgcn_mfma_f32_32x32x16_bf16(*(const ATT_LAS bf16x8*)(Kt + ka + 32 * ks), qf[ks], s, 0, 0, 0);
                float ls0 = 0.f, ls1 = 0.f, ls2 = 0.f, ls3 = 0.f;
#pragma unroll
                for (int r = 0; r < 16; r += 4) { s[r] = __builtin_amdgcn_exp2f(s[r]); s[r + 1] = __builtin_amdgcn_exp2f(s[r + 1]); s[r + 2] = __builtin_amdgcn_exp2f(s[r + 2]); s[r + 3] = __builtin_amdgcn_exp2f(s[r + 3]);
                    ls0 += s[r]; ls1 += s[r + 1]; ls2 += s[r + 2]; ls3 += s[r + 3]; }
                l += (ls0 + ls1) + (ls2 + ls3);
                bf16x8 pf[2];
#pragma unroll
                for (int ss = 0; ss < 2; ++ss) {
                    u32x4 w;
                    w.x = pg8::cvt_pk_bf16(s[8 * ss + 0], s[8 * ss + 1]); w.y = pg8::cvt_pk_bf16(s[8 * ss + 2], s[8 * ss + 3]); w.z = pg8::cvt_pk_bf16(s[8 * ss + 4], s[8 * ss + 5]); w.w = pg8::cvt_pk_bf16(s[8 * ss + 6], s[8 * ss + 7]);
                    pf[ss] = __builtin_bit_cast(bf16x8, w);
                }
#pragma unroll
                for (int db = 0; db < C::NDB; ++db)
#pragma unroll
                    for (int ss = 0; ss < 2; ++ss) {
                        const s16x4 lo = vtr(Vt + va + 64 * db + C::VP * (16 * ss)), hh = vtr(Vt + va + 64 * db + C::VP * (16 * ss + 8));
                        const bf16x8 vf = (bf16x8){lo[0], lo[1], lo[2], lo[3], hh[0], hh[1], hh[2], hh[3]};
                        O[db] = __builtin_amdgcn_mfma_f32_32x32x16_bf16(vf, pf[ss], O[db], 0, 0, 0);
                    }
            }
        }
        __syncthreads();
    }
    if constexpr (MOBA) {
        auto moba_step = [&](const int i, auto own_tag) __attribute__((always_inline)) {
            constexpr bool OWN = decltype(own_tag)::value;

        if (i + 1 < T) ATT_WRITE((i + 1) & 1);
        if (i + 2 < T) ATT_LOAD(ATT_KPOS(i + 2));
        const int kp0 = ATT_KPOS(i);
        const int khi = t - kp0;
        const bool rowsel = OWN ? (khi >= 0) : (((selbits >> ((i - 4) >> 2)) & 1u) != 0u);
        if (__any(rowsel)) {
            const float lbv = rowsel ? slope2 * (float)(kp0 + 4 * hi - t) - SHIFT : NEG;
            const ATT_LAS unsigned char* Kt = lds + (i & 1) * C::STG;
            const ATT_LAS unsigned char* Vt = lds + (i & 1) * C::STG + C::KBYTES;
            f32x16 s0, s1;
#pragma unroll
            for (int r = 0; r < 16; ++r) { const float cr = (float)((r & 3) + 8 * (r >> 2)); s0[r] = __builtin_fmaf(slope2, cr, lbv); s1[r] = __builtin_fmaf(slope2, cr + 32.f, lbv); }
            if constexpr (OWN) {
#pragma unroll
                for (int r = 0; r < 16; ++r) { const int d0 = khi - (4 * hi + (r & 3) + 8 * (r >> 2));
                    s0[r] += __builtin_bit_cast(float, (d0 >> 31) & 0xF149F2CA);
                    s1[r] += __builtin_bit_cast(float, ((d0 - 32) >> 31) & 0xF149F2CA); }
            }
#pragma unroll
            for (int ks = 0; ks < C::NKS; ++ks) s0 = __builtin_amdgcn_mfma_f32_32x32x16_bf16(*(const ATT_LAS bf16x8*)(Kt + ka + 32 * ks), qf[ks], s0, 0, 0, 0);
            __builtin_amdgcn_sched_barrier(0);
            bf16x8 pf0[2], pf1[2];
            {
#pragma unroll
                for (int ks = 0; ks < C::NKS; ++ks) s1 = __builtin_amdgcn_mfma_f32_32x32x16_bf16(*(const ATT_LAS bf16x8*)(Kt + 32 * C::KP + ka + 32 * ks), qf[ks], s1, 0, 0, 0);
                float ls0 = 0.f, ls1 = 0.f, ls2 = 0.f, ls3 = 0.f;
#pragma unroll
                for (int r = 0; r < 16; r += 4) { s0[r] = __builtin_amdgcn_exp2f(s0[r]); s0[r + 1] = __builtin_amdgcn_exp2f(s0[r + 1]); s0[r + 2] = __builtin_amdgcn_exp2f(s0[r + 2]); s0[r + 3] = __builtin_amdgcn_exp2f(s0[r + 3]);
                    ls0 += s0[r]; ls1 += s0[r + 1]; ls2 += s0[r + 2]; ls3 += s0[r + 3]; }
                l += (ls0 + ls1) + (ls2 + ls3);
#pragma unroll
                for (int ss = 0; ss < 2; ++ss) { u32x4 w;
                    w.x = pg8::cvt_pk_bf16(s0[8 * ss + 0], s0[8 * ss + 1]); w.y = pg8::cvt_pk_bf16(s0[8 * ss + 2], s0[8 * ss + 3]); w.z = pg8::cvt_pk_bf16(s0[8 * ss + 4], s0[8 * ss + 5]); w.w = pg8::cvt_pk_bf16(s0[8 * ss + 6], s0[8 * ss + 7]);
                    pf0[ss] = __builtin_bit_cast(bf16x8, w); }
            }
            __builtin_amdgcn_sched_barrier(0);
            {
#pragma unroll
                for (int db = 0; db < C::NDB; ++db)
#pragma unroll
                    for (int ss = 0; ss < 2; ++ss) {
                        const s16x4 lo = vtr(Vt + va + 64 * db + C::VP * (16 * ss)), hh = vtr(Vt + va + 64 * db + C::VP * (16 * ss + 8));
                        const bf16x8 vf = (bf16x8){lo[0], lo[1], lo[2], lo[3], hh[0], hh[1], hh[2], hh[3]};
                        O[db] = __builtin_amdgcn_mfma_f32_32x32x16_bf16(vf, pf0[ss], O[db], 0, 0, 0);
                    }
                float ls0 = 0.f, ls1 = 0.f, ls2 = 0.f, ls3 = 0.f;
#pragma unroll
                for (int r = 0; r < 16; r += 4) { s1[r] = __builtin_amdgcn_exp2f(s1[r]); s1[r + 1] = __builtin_amdgcn_exp2f(s1[r + 1]); s1[r + 2] = __builtin_amdgcn_exp2f(s1[r + 2]); s1[r + 3] = __builtin_amdgcn_exp2f(s1[r + 3]);
                    ls0 += s1[r]; ls1 += s1[r + 1]; ls2 += s1[r + 2]; ls3 += s1[r + 3]; }
                l += (ls0 + ls1) + (ls2 + ls3);
#pragma unroll
                for (int ss = 0; ss < 2; ++ss) { u32x4 w;
                    w.x = pg8::cvt_pk_bf16(s1[8 * ss + 0], s1[8 * ss + 1]); w.y = pg8::cvt_pk_bf16(s1[8 * ss + 2], s1[8 * ss + 3]); w.z = pg8::cvt_pk_bf16(s1[8 * ss + 4], s1[8 * ss + 5]); w.w = pg8::cvt_pk_bf16(s1[8 * ss + 6], s1[8 * ss + 7]);
                    pf1[ss] = __builtin_bit_cast(bf16x8, w); }
            }
            __builtin_amdgcn_sched_barrier(0);
#pragma unroll
            for (int db = 0; db < C::NDB; ++db)
#pragma unroll
                for (int ss = 0; ss < 2; ++ss) {
                    const s16x4 lo = vtr(Vt + 32 * C::VP + va + 64 * db + C::VP * (16 * ss)), hh = vtr(Vt + 32 * C::VP + va + 64 * db + C::VP * (16 * ss + 8));
                    const bf16x8 vf = (bf16x8){lo[0], lo[1], lo[2], lo[3], hh[0], hh[1], hh[2], hh[3]};
                    O[db] = __builtin_amdgcn_mfma_f32_32x32x16_bf16(vf, pf1[ss], O[db], 0, 0, 0);
                }
            __builtin_amdgcn_sched_barrier(0);
        }
        __syncthreads();
            };
        for (int i = 0; i < 4; ++i) moba_step(i, std::true_type{});
        for (int i = 4; i < T; ++i) moba_step(i, std::false_type{});
    }
#undef ATT_KPOS
#undef ATT_LOAD
#undef ATT_WRITE
    float lt = l + __shfl_xor(l, 32);
    if constexpr (!MOBA) lt += __builtin_amdgcn_exp2f(p.sinks[head] * LOG2E - SHIFT);
    const float inv = 1.0f / lt;
    if constexpr (MOBA) {
        constexpr int OP = 272;
        ATT_LAS unsigned char* tb = lds + wave * (32 * OP);
#pragma unroll
        for (int db = 0; db < C::NDB; ++db)
#pragma unroll
            for (int g = 0; g < 4; ++g) {
                u32x2 w; w.x = pg8::cvt_pk_bf16(O[db][4 * g] * inv, O[db][4 * g + 1] * inv); w.y = pg8::cvt_pk_bf16(O[db][4 * g + 2] * inv, O[db][4 * g + 3] * inv);
                *(ATT_LAS u32x2*)(tb + q * OP + (32 * db + 8 * g + 4 * hi) * 2) = w;
            }
        bf16_t* Ow = (bf16_t*)(ws + WS_XN) + (size_t)(seqbase + qpos0 + 32 * wave) * 2048 + 1024 + head * 128 + 8 * (lane & 15);
#pragma unroll
        for (int j = 0; j < 8; ++j) {
            const int r = 4 * j + (lane >> 4);
            const u32x4 o = *(const ATT_LAS u32x4*)(tb + r * OP + 16 * (lane & 15));
            *(u32x4*)(Ow + (size_t)r * 2048) = o;
        }
        __syncthreads();
    } else {
#pragma unroll
        for (int db = 0; db < C::NDB; ++db)
#pragma unroll
            for (int g = 0; g < 4; ++g) {
                u32x2 w; w.x = pg8::cvt_pk_bf16(O[db][4 * g] * inv, O[db][4 * g + 1] * inv); w.y = pg8::cvt_pk_bf16(O[db][4 * g + 2] * inv, O[db][4 * g + 3] * inv);
                *(u32x2*)(Orow + 32 * db + 8 * g + 4 * hi) = w;
            }
    }
}

__device__ __forceinline__ void swa_phase(ATT_LAS unsigned char* lds, const Params& p, int bid, int nblk) {
    typedef Cfg<64> C;
    constexpr int TILE = C::STG, UBUF = 3 * TILE;
    const int tid = opaque_tid(), lane = tid & 63, wave = __builtin_amdgcn_readfirstlane(tid >> 6), q = lane & 31, hi = lane >> 5;
    unsigned char* ws = p.ws;
    const bf16_t *QA = (const bf16_t*)(ws + WS_QA), *KA = (const bf16_t*)(ws + WS_KA), *VA = (const bf16_t*)(ws + WS_VA);
    bf16_t* OAB = (bf16_t*)(ws + WS_XN);
    const int prow = tid >> 3, pch = tid & 7;
    const int lk = C::KP * prow + 16 * pch, lv = C::KBYTES + C::VP * prow + 16 * pch;
    const int ka = C::KP * q + 16 * hi;
    const int va = C::VP * (4 * hi + ((lane & 15) >> 2)) + 32 * ((lane >> 4) & 1) + 8 * (lane & 3);
    u32x4 kreg[3], vreg[3]; bf16x8 qn[C::NKS];
#define SWA_DEC(u, b_, g_, n_) const int _x##n_ = (u) & 7, _i##n_ = (u) >> 3, _bg##n_ = _x##n_ * 4 + (_i##n_ >> 5); const int b_ = _bg##n_ >> 2, g_ = _bg##n_ & 3, n_ = _i##n_ & 31
#define SWA_LOAD(u) do { SWA_DEC(u, b_, g_, n_); \
        const bf16_t* kt = KA + ((size_t)(b_ * SEQ + 64 * n_ + prow)) * 256 + g_ * 64 + pch * 8; const bf16_t* vt = VA + ((size_t)(b_ * SEQ + 64 * n_ + prow)) * 256 + g_ * 64 + pch * 8; \
        _Pragma("unroll") for (int _i = 0; _i < 3; ++_i) if (_i <= n_) { kreg[_i] = *(const u32x4*)(kt - (size_t)_i * 64 * 256); vreg[_i] = *(const u32x4*)(vt - (size_t)_i * 64 * 256); } \
        const bf16_t* qr = QA + ((size_t)(b_ * SEQ + 64 * n_ + 32 * (wave & 1) + q)) * 1024 + (4 * g_ + (wave >> 1)) * 64; \
        _Pragma("unroll") for (int ks = 0; ks < C::NKS; ++ks) qn[ks] = *(const bf16x8*)(qr + 16 * ks + 8 * hi); } while (0)
#define SWA_WRITE(u, buf) do { SWA_DEC(u, b_, g_, n_); (void)b_; (void)g_; \
        _Pragma("unroll") for (int _i = 0; _i < 3; ++_i) if (_i <= n_) { *(ATT_LAS u32x4*)(lds + (buf) * UBUF + _i * TILE + lk) = kreg[_i]; *(ATT_LAS u32x4*)(lds + (buf) * UBUF + _i * TILE + lv) = vreg[_i]; } } while (0)
    if (bid >= 1024) return;
    SWA_LOAD(bid); SWA_WRITE(bid, 0); __syncthreads();
    int j = 0;
    for (int u = bid; u < 1024; u += nblk, ++j) {
        bf16x8 qf[C::NKS];
#pragma unroll
        for (int ks = 0; ks < C::NKS; ++ks) qf[ks] = qn[ks];
        const int un = u + nblk; const bool more = un < 1024;
        if (more) SWA_LOAD(un);
        SWA_DEC(u, b, g, n);
        const int head = 4 * g + (wave >> 1), qpos0 = 64 * n, t = qpos0 + 32 * (wave & 1) + q;
        const float slope2 = exp2f(-0.5f * (float)(head + 1)) * LOG2E;
        f32x16 O[C::NDB];
#pragma unroll
        for (int db = 0; db < C::NDB; ++db)
#pragma unroll
            for (int r = 0; r < 16; ++r) O[db][r] = 0.f;
        float l = 0.f;
        const int sgn = wave & 1;
        const ATT_LAS unsigned char* ub = lds + (j & 1) * UBUF;
#define SWA_HALF(J, GUARD) do { if (!(GUARD) || (J) <= 2 * n + sgn) { \
            const int g_ = 1 - sgn + (J); \
            const ATT_LAS unsigned char* Kt = ub + (g_ >> 1) * TILE + (1 - (g_ & 1)) * 32 * C::KP; \
            const ATT_LAS unsigned char* Vt = ub + (g_ >> 1) * TILE + C::KBYTES + (1 - (g_ & 1)) * 32 * C::VP; \
            const float lb = slope2 * (float)(4 * hi - 32 * (J) - q) - SHIFT; \
            f32x16 s; \
            _Pragma("unroll") for (int r = 0; r < 16; ++r) { const int ko = 4 * hi + (r & 3) + 8 * (r >> 2); const float v = __builtin_fmaf(slope2, (float)((r & 3) + 8 * (r >> 2)), lb); \
                s[r] = ((J) == 0) ? (ko <= q ? v : NEG) : ((J) == 4) ? (ko >= q + 1 ? v : NEG) : v; } \
            _Pragma("unroll") for (int ks = 0; ks < C::NKS; ++ks) s = __builtin_amdgcn_mfma_f32_32x32x16_bf16(*(const ATT_LAS bf16x8*)(Kt + ka + 32 * ks), qf[ks], s, 0, 0, 0); \
            float ls0 = 0.f, ls1 = 0.f, ls2 = 0.f, ls3 = 0.f; \
            _Pragma("unroll") for (int r = 0; r < 16; r += 4) { s[r] = __builtin_amdgcn_exp2f(s[r]); s[r + 1] = __builtin_amdgcn_exp2f(s[r + 1]); s[r + 2] = __builtin_amdgcn_exp2f(s[r + 2]); s[r + 3] = __builtin_amdgcn_exp2f(s[r + 3]); \
                ls0 += s[r]; ls1 += s[r + 1]; ls2 += s[r + 2]; ls3 += s[r + 3]; } \
            l += (ls0 + ls1) + (ls2 + ls3); \
            bf16x8 pf[2]; \
            _Pragma("unroll") for (int ss = 0; ss < 2; ++ss) { u32x4 w; \
                w.x = pg8::cvt_pk_bf16(s[8 * ss + 0], s[8 * ss + 1]); w.y = pg8::cvt_pk_bf16(s[8 * ss + 2], s[8 * ss + 3]); w.z = pg8::cvt_pk_bf16(s[8 * ss + 4], s[8 * ss + 5]); w.w = pg8::cvt_pk_bf16(s[8 * ss + 6], s[8 * ss + 7]); \
                pf[ss] = __builtin_bit_cast(bf16x8, w); } \
            _Pragma("unroll") for (int db = 0; db < C::NDB; ++db) _Pragma("unroll") for (int ss = 0; ss < 2; ++ss) { \
                const s16x4 lo = vtr(Vt + va + 64 * db + C::VP * (16 * ss)), hh = vtr(Vt + va + 64 * db + C::VP * (16 * ss + 8)); \
                const bf16x8 vf = (bf16x8){lo[0], lo[1], lo[2], lo[3], hh[0], hh[1], hh[2], hh[3]}; \
                O[db] = __builtin_amdgcn_mfma_f32_32x32x16_bf16(vf, pf[ss], O[db], 0, 0, 0); } } } while (0)
        if (n >= 2) { SWA_HALF(0, false); SWA_HALF(1, false); SWA_HALF(2, false); SWA_HALF(3, false); SWA_HALF(4, false); }
        else        { SWA_HALF(0, true);  SWA_HALF(1, true);  SWA_HALF(2, true);  SWA_HALF(3, true);  SWA_HALF(4, true); }
#undef SWA_HALF
        const float lt = l + __shfl_xor(l, 32) + __builtin_amdgcn_exp2f(p.sinks[head] * LOG2E - SHIFT);
        const float inv = 1.0f / lt;
        bf16_t* Orow = OAB + (size_t)(b * SEQ + t) * 2048 + head * 64;
#pragma unroll
        for (int db = 0; db < C::NDB; ++db)
#pragma unroll
            for (int gq = 0; gq < 4; ++gq) {
                u32x2 w; w.x = pg8::cvt_pk_bf16(O[db][4 * gq] * inv, O[db][4 * gq + 1] * inv); w.y = pg8::cvt_pk_bf16(O[db][4 * gq + 2] * inv, O[db][4 * gq + 3] * inv);
                *(u32x2*)(Orow + 32 * db + 8 * gq + 4 * hi) = w;
            }
        if (more) SWA_WRITE(un, (j + 1) & 1);
        __syncthreads();
    }
#undef SWA_DEC
#undef SWA_LOAD
#undef SWA_WRITE
}

__device__ __forceinline__ void attn_phase(ATT_LAS unsigned char* lds, const Params& p, int bid, int nblk) {
    for (int uu = 0;; ++uu) {
        const int it = bid + (uu >> 1) * nblk; if (it >= 256) break;
        const int x = it & 7, idx = it >> 3, bh = x * 8 + (idx >> 2), s = idx & 3;
        attn_unit<128, true>(lds, p, bh >> 3, bh & 7, (uu & 1) ? 7 - s : s);
    }
    __syncthreads();
    swa_phase(lds, p, bid, nblk);
}
}

#define XB_TMO      128
#define XB_XCNT(j)  (256  + 64 * (j))
#define XB_XSUB(j)  (1280 + 64 * (j))
#define XB_XGEN(j)  (2304 + 64 * (j))
#define XB_TOP      3328
#define XB_TOPGEN   3392
#define XCD_BAR_WORDS 3456
#define XB_SPIN_CAP (1u << 18)
#define XLAS __attribute__((address_space(3)))
__device__ __forceinline__ unsigned xb_ld(unsigned* p)              { return __hip_atomic_load(p, __ATOMIC_RELAXED, __HIP_MEMORY_SCOPE_AGENT); }
__device__ __forceinline__ unsigned xb_add(unsigned* p, unsigned v) { return __hip_atomic_fetch_add(p, v, __ATOMIC_RELAXED, __HIP_MEMORY_SCOPE_AGENT); }
__device__ __forceinline__ unsigned xb_xcc_id() { return (unsigned)__builtin_amdgcn_s_getreg((3 << 11) | 20) & 0xFu; }
#define XB_SPIN(cond, bar) do { unsigned _sp = 0; while (cond) { __builtin_amdgcn_s_sleep(1); \
    if ((++_sp & 255u) == 0u) { if (xb_ld(&(bar)[XB_TMO])) break; if (_sp > XB_SPIN_CAP) { atomicAdd(&(bar)[XB_TMO], 1u); break; } } } } while (0)
struct XcdBarrier { unsigned* bar; unsigned x; volatile XLAS unsigned* st; };
__device__ __forceinline__ XcdBarrier xcd_barrier_post(unsigned* bar, volatile XLAS unsigned* st) {
    XcdBarrier b; b.bar = bar; b.x = xb_xcc_id(); b.st = st;
    if (threadIdx.x == 0) (void)xb_add(&bar[XB_XCNT(b.x)], 1u);
    return b;
}
__device__ __forceinline__ void xcd_barrier_complete(unsigned* bar, unsigned x, unsigned& nloc, unsigned& nx) {
    const unsigned G = gridDim.x * gridDim.y * gridDim.z;
    unsigned sum, cnt, mine, sp = 0u;
    for (;;) {
        sum = 0u; cnt = 0u; mine = 0u;
#pragma unroll
        for (unsigned j = 0; j < 16; ++j) { const unsigned c = xb_ld(&bar[XB_XCNT(j)]); sum += c; cnt += (c > 0u) ? 1u : 0u; mine = (j == x) ? c : mine; }
        if (sum == G) break;
        __builtin_amdgcn_s_sleep(1);
        if ((++sp & 255u) == 0u) { if (xb_ld(&bar[XB_TMO])) break; if (sp > XB_SPIN_CAP) { atomicAdd(&bar[XB_TMO], 1u); break; } }
    }
    nloc = mine > 0u ? mine : 1u; nx = cnt > 0u ? cnt : 1u;
}
__device__ __forceinline__ void xcd_barrier(const XcdBarrier& b) {
    asm volatile("s_waitcnt vmcnt(0)" ::: "memory");
    __syncthreads();
    if (threadIdx.x == 0) {
        unsigned* bar = b.bar;
        __builtin_amdgcn_s_waitcnt(0);
        unsigned nloc = b.st[0], nx = b.st[1];
        if (nloc == 0u) { xcd_barrier_complete(bar, b.x, nloc, nx); b.st[0] = nloc; b.st[1] = nx; }
        const unsigned old = xb_add(&bar[XB_XSUB(b.x)], 1u);
        const unsigned gen = old / nloc;
        if (old + 1u == (gen + 1u) * nloc) {
            __builtin_amdgcn_fence(__ATOMIC_RELEASE, "agent");
            asm volatile("s_waitcnt vmcnt(0)" ::: "memory");
            const unsigned og = xb_add(&bar[XB_TOP], 1u);
            const unsigned tg = og / nx;
            if (og + 1u == (tg + 1u) * nx) xb_add(&bar[XB_TOPGEN], 1u);
            else XB_SPIN(xb_ld(&bar[XB_TOPGEN]) == tg, bar);
            __builtin_amdgcn_fence(__ATOMIC_ACQUIRE, "agent");
            xb_add(&bar[XB_XGEN(b.x)], 1u);
            asm volatile("s_waitcnt vmcnt(0)" ::: "memory");
        } else {
            XB_SPIN(xb_ld(&bar[XB_XGEN(b.x)]) == gen, bar);
            __builtin_amdgcn_fence(__ATOMIC_ACQUIRE, "agent");
            asm volatile("s_waitcnt vmcnt(0)" ::: "memory");
        }
    }
    __syncthreads();
}

constexpr int LDS_BYTES = 147456, MISC_OFF = 131072 + 320, XCH_OFF = 131072 + 1024;
#define GRID_SYNC() xcd_barrier(xbar)
#define XB_CLUSTER(k) (4096 + 64 * (k))
__device__ __forceinline__ void cluster_barrier(unsigned* bar, int k, unsigned target) {
    asm volatile("s_waitcnt vmcnt(0)" ::: "memory");
    __syncthreads();
    if (threadIdx.x == 0) {
        __builtin_amdgcn_fence(__ATOMIC_RELEASE, "agent");
        asm volatile("s_waitcnt vmcnt(0)" ::: "memory");
        (void)xb_add(&bar[XB_CLUSTER(k)], 1u);
        XB_SPIN(xb_ld(&bar[XB_CLUSTER(k)]) < target, bar);
        __builtin_amdgcn_fence(__ATOMIC_ACQUIRE, "agent");
        asm volatile("s_waitcnt vmcnt(0)" ::: "memory");
    }
    __syncthreads();
}
#ifndef P1_LAG_TICKS
#define P1_LAG_TICKS 1200
#endif
#ifndef PROBE_P0
#define PROBE_P0 1
#endif
#ifndef PROBE_P1
#define PROBE_P1 1
#endif
#ifndef PROBE_P15
#define PROBE_P15 1
#endif
#ifndef PROBE_ATT
#define PROBE_ATT 1
#endif
#ifndef PROBE_P3
#define PROBE_P3 1
#endif
#ifndef PROBE_P5
#define PROBE_P5 1
#endif
__global__ void __launch_bounds__(NTHREADS, 2) fwd_megakernel(Params p) {
    extern __shared__ __attribute__((aligned(16))) unsigned char lds[];
    const int bid = blockIdx.x, nblk = gridDim.x;
    unsigned char* ws = p.ws;
    PG8_LAS unsigned char* ring = (PG8_LAS unsigned char*)lds;
    volatile XLAS unsigned* misc = (volatile XLAS unsigned*)((XLAS unsigned char*)lds + MISC_OFF);
    if (threadIdx.x < 8) misc[threadIdx.x] = 0u;
    __syncthreads();
    const XcdBarrier xbar = xcd_barrier_post((unsigned*)(ws + WS_CTL), misc);
    const bool clustered = (nblk == 256); const int cluster = 8 * (bid & 7) + ((bid >> 3) & 7); const unsigned csize = 4u;
#define SEAM_SYNC(n) do { if (clustered) cluster_barrier((unsigned*)(ws + WS_CTL), cluster, (unsigned)(n) * csize); else GRID_SYNC(); } while (0)
    const int n9 = (M / 256) * (NIN / 256) - 8 * nblk; const bool defer_late = (nblk == 256);
    { p0_prologue(p, defer_late, bid, nblk, (P0_LAS unsigned char*)lds); GRID_SYNC(); }
#if PROBE_P0 > 1
    { p0_prologue(p, defer_late, bid, nblk, (P0_LAS unsigned char*)lds); GRID_SYNC(); }
#endif

    {
        if (defer_late && bid >= n9) { const int lw = (bid - n9) * NWAVES + (threadIdx.x >> 6), LNW = (nblk - n9) * NWAVES;
            p0_weights<1>(p, lw, LNW, (P0_LAS unsigned char*)lds); p0_weights<2>(p, lw, LNW, (P0_LAS unsigned char*)lds); __syncthreads(); }
        pg8::Gemm g{(const bf16_t*)(ws + WS_XN), (const bf16_t*)(ws + WS_WIN), 2048, 2048, 32, 0}; pg8::TileOrder<1> S; S.init(M, NIN, nblk, bid);
        pg8::EpiZ E{ws, p.b_gate, p.qna, p.kna, p.knb, (PG8_LAS float*)((PG8_LAS unsigned char*)lds + XCH_OFF)}; pg8::gemm_phase(ring, g, S, E); GRID_SYNC(); }
#if PROBE_P1 > 1
    {
        pg8::Gemm g{(const bf16_t*)(ws + WS_XN), (const bf16_t*)(ws + WS_WIN), 2048, 2048, 32, 0}; pg8::TileOrder<1> S; S.init(M, NIN, nblk, bid);
        pg8::EpiZ E{ws, p.b_gate, p.qna, p.kna, p.knb, (PG8_LAS float*)((PG8_LAS unsigned char*)lds + XCH_OFF)}; pg8::gemm_phase(ring, g, S, E); GRID_SYNC(); }
#endif

    { att::attn_phase((ATT_LAS unsigned char*)lds, p, bid, nblk); GRID_SYNC(); }
#if PROBE_ATT > 1
    { att::attn_phase((ATT_LAS unsigned char*)lds, p, bid, nblk); GRID_SYNC(); }
#endif

    {
        pg8::Gemm g{(const bf16_t*)(ws + WS_XN), (const bf16_t*)(ws + WS_WAB), 2048, 2048, 16, 1024}; pg8::TileOrder<2> S; S.init(M, DM, nblk, bid);
        pg8::EpiMixed E{(const bf16_t*)(ws + WS_GATES), (bf16_t*)(ws + WS_MIXED)}; pg8::gemm_phase(ring, g, S, E); SEAM_SYNC(1); }

    { pg8::Gemm g{(const bf16_t*)(ws + WS_MIXED), (const bf16_t*)(ws + WS_WO), 4096, 2048, 32, 0}; pg8::TileOrder<1> S; S.init(M, DM, nblk, bid);
      pg8::EpiWo E{p.x, p.out, (bf16_t*)(ws + WS_XN), (float*)(ws + WS_SUMSQ)}; pg8::gemm_phase(ring, g, S, E); }
    SEAM_SYNC(2);
    {
        pg8::Gemm g{(const bf16_t*)(ws + WS_XN), (const bf16_t*)(ws + WS_WGU), 2048, 2048, 32, 0}; pg8::TileOrder<1> S; S.init(M, 2 * DFF, nblk, bid);
        pg8::EpiSwiglu E{(const float*)(ws + WS_SUMSQ), (bf16_t*)(ws + WS_ACT)}; pg8::gemm_phase(ring, g, S, E); SEAM_SYNC(3); }

    { pg8::Gemm g{(const bf16_t*)(ws + WS_ACT), (const bf16_t*)(ws + WS_WD), DFF, DFF, DFF / 64, 0, (unsigned)ACT_GAP, ACT_GAP_FROM}; pg8::TileOrder<1> S; S.init(M, DM, nblk, bid);
      pg8::EpiDown E{p.out, (const bf16_t*)(ws + WS_XN)}; pg8::gemm_phase(ring, g, S, E); }
}

extern "C" void kernel_launch(void* const* d_in, const int* in_sizes, int n_in, void* d_out, int out_size, void* d_ws, size_t ws_size, hipStream_t stream) {
    if (n_in != 16 || ws_size < WS_END) { fprintf(stderr, "kernel_launch: unexpected n_in %d / ws_size %zu\n", n_in, ws_size); return; }
    static int grid_blocks = 0;
    if (!grid_blocks) {
        int dev = 0, cus = 0, per_cu = 0;
        (void)hipGetDevice(&dev);
        (void)hipDeviceGetAttribute(&cus, hipDeviceAttributeMultiprocessorCount, dev);
        (void)hipFuncSetAttribute((const void*)fwd_megakernel, hipFuncAttributeMaxDynamicSharedMemorySize, LDS_BYTES);
        (void)hipOccupancyMaxActiveBlocksPerMultiprocessor(&per_cu, (const void*)fwd_megakernel, NTHREADS, LDS_BYTES);
        if (per_cu < 1) per_cu = 1;
        grid_blocks = cus * per_cu;
        fprintf(stderr, "kernel_launch: cus %d per_cu %d grid %d\n", cus, per_cu, grid_blocks);
    }
    Params p{};
    p.x = (const float*)d_in[0]; p.norm1_g = (const float*)d_in[1]; p.w_in = (const float*)d_in[2]; p.b_gate = (const float*)d_in[3];
    p.qna = (const float*)d_in[4]; p.kna = (const float*)d_in[5]; p.sinks = (const float*)d_in[6]; p.qnb = (const float*)d_in[7]; p.knb = (const float*)d_in[8];
    p.wba = (const float*)d_in[9]; p.wbb = (const float*)d_in[10]; p.wo = (const float*)d_in[11]; p.norm2_g = (const float*)d_in[12];
    p.wg = (const float*)d_in[13]; p.wu = (const float*)d_in[14]; p.wd = (const float*)d_in[15];
    p.out = (float*)d_out; p.ws = (unsigned char*)d_ws;
    (void)hipMemsetAsync((char*)d_ws + WS_CTL, 0, 32768, stream);
    void* args[] = {&p};
    hipError_t e = hipLaunchCooperativeKernel((const void*)fwd_megakernel, dim3(grid_blocks), dim3(NTHREADS), args, LDS_BYTES, stream);
    if (e != hipSuccess) fprintf(stderr, "cooperative launch failed: %s (grid %d)\n", hipGetErrorString(e), grid_blocks);
}
```

```cpp
#include <hip/hip_runtime.h>
#include <stdint.h>
#include <type_traits>
#include <cstdio>

typedef unsigned short bf16_t;
typedef short bf16x8 __attribute__((ext_vector_type(8)));
typedef float f32x4 __attribute__((ext_vector_type(4)));
typedef unsigned u32x4 __attribute__((ext_vector_type(4)));
typedef unsigned u32x2 __attribute__((ext_vector_type(2)));

constexpr int BATCH = 8, SEQ = 2048, DM = 2048, M = BATCH * SEQ;
constexpr int NIN = 8704, DFF = 5632;
constexpr int C_QA = 0, C_KA = 1024, C_VA = 1280, C_QB = 1536, C_KB = 2560, C_VB = 3584, C_G = 4608;
constexpr float RMS_EPS = 1e-6f;
constexpr float LOG2E = 1.4426950408889634f;
constexpr float SC_QA = 0.125f * LOG2E, SC_QB = 0.08838834764831845f * LOG2E;
constexpr int NWAVES = 8, NTHREADS = 512;

constexpr size_t MiB = 1u << 20;
constexpr size_t WS_CTL = 0;
constexpr size_t WS_SUMSQ = 1 * MiB;
constexpr size_t WS_KMEAN = 1 * MiB + 128 * 1024;
constexpr size_t WS_WIN = 2 * MiB;
constexpr size_t WS_WAB = 36 * MiB;
constexpr size_t WS_WO = 44 * MiB;
constexpr size_t WS_WGU = 52 * MiB;
constexpr size_t WS_WD = 96 * MiB;
constexpr size_t WS_XN = 118 * MiB;
constexpr size_t WS_QA = 182 * MiB;
constexpr size_t WS_KA = 214 * MiB;
constexpr size_t WS_VA = 222 * MiB;
constexpr size_t WS_QB = 230 * MiB;
constexpr size_t WS_KB = 262 * MiB;
constexpr size_t WS_VB = 294 * MiB;
constexpr size_t WS_GATES = 326 * MiB;
constexpr size_t WS_MIXED = WS_GATES;
constexpr size_t WS_ACT = 182 * MiB;
constexpr int    ACT_GAP_FROM = 52;
constexpr size_t ACT_GAP = (454 - 182) * MiB - (size_t)ACT_GAP_FROM * 256 * 5632 * 2;
constexpr size_t WS_END = 487 * MiB;

struct Params {
    const float *x, *norm1_g, *w_in, *b_gate, *qna, *kna, *sinks, *qnb, *knb, *wba, *wbb, *wo, *norm2_g, *wg, *wu, *wd;
    float* out; unsigned char* ws;
};

__device__ __forceinline__ int opaque_tid() { int t = threadIdx.x; asm volatile("" : "+v"(t)); return t; }
__device__ __forceinline__ unsigned f2bf(float f) { unsigned u = __builtin_bit_cast(unsigned, f); return (u + 0x7fffu + ((u >> 16) & 1u)) >> 16; }
__device__ __forceinline__ unsigned pk2(float lo, float hi) { return f2bf(lo) | (f2bf(hi) << 16); }
__device__ __forceinline__ float bf2f(unsigned short b) { return __builtin_bit_cast(float, (unsigned)b << 16); }
__device__ __forceinline__ float bflo(unsigned w) { return __builtin_bit_cast(float, w << 16); }
__device__ __forceinline__ float bfhi(unsigned w) { return __builtin_bit_cast(float, w & 0xffff0000u); }
__device__ __forceinline__ float wave_sum(float v) {
#pragma unroll
    for (int o = 1; o < 64; o <<= 1) v += __shfl_xor(v, o);
    return v;
}
__device__ __forceinline__ float wave_max(float v) {
#pragma unroll
    for (int o = 1; o < 64; o <<= 1) v = fmaxf(v, __shfl_xor(v, o));
    return v;
}

typedef float f32x2_t __attribute__((ext_vector_type(2))); typedef __bf16 bf16x2_t __attribute__((ext_vector_type(2)));
__device__ __forceinline__ unsigned cvt2(float lo, float hi) { f32x2_t v = {lo, hi}; bf16x2_t b = __builtin_convertvector(v, bf16x2_t); return __builtin_bit_cast(unsigned, b); }
#define P0_LAS __attribute__((address_space(3)))
__device__ __forceinline__ int p0_drow(int n, int mapk) {
    if (mapk == 0) return n;
    if (mapk == 3 || (mapk == 4 && n < C_G)) return (n & ~255) + 128 * ((n >> 5) & 1) + 32 * ((n >> 6) & 3) + (n & 31);
    if (mapk == 4) { const int g = (n >= C_G + 2048) ? 1 : 0, c = n - C_G - 2048 * g; return C_G + 256 * (c >> 7) + 128 * g + (c & 127); }
    return 256 * (n >> 7) + (n & 127) + (mapk == 2 ? 128 : 0);
}
struct WItem { const float* src; const float* ks; bf16_t* d; int ldw, ldd, n0, mapk; };
__device__ __forceinline__ WItem p0_mk(const float* W, int ldw, int n0, int k0, const float* kscale, bf16_t* dst, int ldd, int dstk0, int mapk, int lane) {
    const int l = lane & 31, h = lane >> 5;
    WItem it; it.src = W + (size_t)(k0 + 16 * h) * ldw + n0 + 4 * l; it.ks = kscale ? kscale + k0 + 16 * h : nullptr;
    it.d = dst + dstk0 + k0 + 8 * (lane & 7); it.ldw = ldw; it.ldd = ldd; it.n0 = n0; it.mapk = mapk; return it;
}
__device__ __forceinline__ void p0_ld(const WItem& it, int b, f32x4 (&v)[16]) {
#pragma unroll
    for (int i = 0; i < 16; ++i) v[i] = __builtin_nontemporal_load((const f32x4*)(it.src + (size_t)(32 * b + i) * it.ldw));
}
__device__ __forceinline__ void p0_tolds(const WItem& it, int b, f32x4 (&v)[16], P0_LAS unsigned char* buf, int lane) {
    if (it.ks) {
#pragma unroll
        for (int i = 0; i < 16; ++i) v[i] = v[i] * it.ks[32 * b + i];
    }
    const int l = lane & 31, h = lane >> 5;
#pragma unroll
    for (int e = 0; e < 4; ++e)
#pragma unroll
        for (int q = 0; q < 2; ++q) {
            u32x4 o; o.x = cvt2(v[8 * q + 0][e], v[8 * q + 1][e]); o.y = cvt2(v[8 * q + 2][e], v[8 * q + 3][e]); o.z = cvt2(v[8 * q + 4][e], v[8 * q + 5][e]); o.w = cvt2(v[8 * q + 6][e], v[8 * q + 7][e]);
            const int c = 4 * b + 2 * h + q;
            *(P0_LAS u32x4*)(buf + (4 * l + e) * 128 + ((c ^ (l & 7)) << 4)) = o;
        }
}
__device__ __forceinline__ void p0_flush(const WItem& it, P0_LAS unsigned char* buf, int lane) {
#pragma unroll
    for (int j = 0; j < 16; ++j) {
        const int r = 8 * j + (lane >> 3), c = lane & 7;
        const u32x4 o = *(const P0_LAS u32x4*)(buf + r * 128 + ((c ^ ((r >> 2) & 7)) << 4));
        *(u32x4*)(it.d + (size_t)p0_drow(it.n0 + r, it.mapk) * it.ldd) = o;
    }
}
template <int SET> __device__ __forceinline__ int p0_count() { return SET == 0 ? 68 * 32 + 2 * 44 * 32 : SET == 1 ? 2 * 16 * 16 + 16 * 32 : 16 * 88; }
template <int SET> __device__ __forceinline__ WItem p0_decode(const Params& p, int r, int lane) {
    unsigned char* ws = p.ws;
    if (SET == 0) {
        constexpr int I_G = 44 * 32;
        if (r < I_G) return p0_mk(p.wg, DFF, 128 * (r >> 5), 64 * (r & 31), p.norm2_g, (bf16_t*)(ws + WS_WGU), 2048, 0, 1, lane);
        r -= I_G;
        if (r < I_G) return p0_mk(p.wu, DFF, 128 * (r >> 5), 64 * (r & 31), p.norm2_g, (bf16_t*)(ws + WS_WGU), 2048, 0, 2, lane);
        r -= I_G;
        return p0_mk(p.w_in, NIN, 128 * (r >> 5), 64 * (r & 31), nullptr, (bf16_t*)(ws + WS_WIN), 2048, 0, 4, lane);
    } else if (SET == 1) {
        constexpr int I_BA = 16 * 16;
        if (r < I_BA) return p0_mk(p.wba, 2048, 128 * (r >> 4), 64 * (r & 15), nullptr, (bf16_t*)(ws + WS_WAB), 2048, 0, 3, lane);
        r -= I_BA;
        if (r < I_BA) return p0_mk(p.wbb, 2048, 128 * (r >> 4), 64 * (r & 15), nullptr, (bf16_t*)(ws + WS_WAB), 2048, 1024, 3, lane);
        r -= I_BA;
        return p0_mk(p.wo, 2048, 128 * (r >> 5), 64 * (r & 31), nullptr, (bf16_t*)(ws + WS_WO), 2048, 0, 3, lane);
    } else {
        return p0_mk(p.wd, 2048, 128 * (r / 88), 64 * (r % 88), nullptr, (bf16_t*)(ws + WS_WD), DFF, 0, 3, lane);
    }
}
template <int SET>
__device__ __forceinline__ void p0_weights(const Params& p, int gw, int NGW, P0_LAS unsigned char* lds) {
    const int tid = opaque_tid(), lane = tid & 63; const int cnt = p0_count<SET>();
    if (gw >= cnt) return;
    P0_LAS unsigned char* buf = lds + (tid >> 6) * 16384;
    f32x4 va[16], vb[16];
    WItem cur = p0_decode<SET>(p, gw, lane);
    p0_ld(cur, 0, va);
    for (int it = gw; it < cnt; it += NGW) {
        p0_ld(cur, 1, vb);
        p0_tolds(cur, 0, va, buf, lane);
        const bool more = it + NGW < cnt;
        WItem nxt = cur;
        if (more) { nxt = p0_decode<SET>(p, it + NGW, lane); p0_ld(nxt, 0, va); }
        p0_tolds(cur, 1, vb, buf, lane);
        p0_flush(cur, buf, lane);
        cur = nxt;
    }
}

__device__ __forceinline__ void p0_prologue(const Params& p, bool defer_late, int bid, int nblk, P0_LAS unsigned char* lds) {
    const int tid = opaque_tid(), lane = tid & 63, wave = tid >> 6;
    const int gw = bid * NWAVES + wave, NGW = nblk * NWAVES;
    unsigned char* ws = p.ws;
    float* z = (float*)(ws + WS_SUMSQ);
    for (int i = bid * NTHREADS + tid; i < 16384; i += nblk * NTHREADS) z[i] = 0.f;
    int* z2 = (int*)(ws + WS_KMEAN);
    for (int i = bid * NTHREADS + tid; i < 65536; i += nblk * NTHREADS) z2[i] = 0;
    if (!defer_late) { p0_weights<2>(p, gw, NGW, lds); p0_weights<1>(p, gw, NGW, lds); }
    p0_weights<0>(p, gw, NGW, lds);
    bf16_t* XN = (bf16_t*)(ws + WS_XN);
    if (gw < M) {
        f32x4 v[8], w[8];
        { const f32x4* xr = (const f32x4*)(p.x + (size_t)gw * DM) + lane;
#pragma unroll
          for (int j = 0; j < 8; ++j) v[j] = __builtin_nontemporal_load(xr + 64 * j); }
        for (int m = gw; m < M; m += NGW) {
            const bool more = m + NGW < M;
            if (more) { const f32x4* xr = (const f32x4*)(p.x + (size_t)(m + NGW) * DM) + lane;
#pragma unroll
                for (int j = 0; j < 8; ++j) w[j] = __builtin_nontemporal_load(xr + 64 * j); }
            float s = 0.f;
#pragma unroll
            for (int j = 0; j < 8; ++j) s += (v[j].x * v[j].x + v[j].y * v[j].y) + (v[j].z * v[j].z + v[j].w * v[j].w);
            const float rstd = rsqrtf(wave_sum(s) * (1.f / DM) + RMS_EPS);
            u32x2* o8 = (u32x2*)(XN + (size_t)m * DM) + lane;
#pragma unroll
            for (int j = 0; j < 8; ++j) { const f32x4 g = ((const f32x4*)p.norm1_g)[64 * j + lane];
                u32x2 o; o.x = cvt2(v[j].x * rstd * g.x, v[j].y * rstd * g.y); o.y = cvt2(v[j].z * rstd * g.z, v[j].w * rstd * g.w);
                o8[64 * j] = o; }
#pragma unroll
            for (int j = 0; j < 8; ++j) v[j] = w[j];
        }
    }
}

__device__ __forceinline__ void unpack8(const u32x4 w, float (&f)[8]) {
    f[0] = bflo(w.x); f[1] = bfhi(w.x); f[2] = bflo(w.y); f[3] = bfhi(w.y); f[4] = bflo(w.z); f[5] = bfhi(w.z); f[6] = bflo(w.w); f[7] = bfhi(w.w);
}
namespace pg8 {
#define PG8_LAS __attribute__((address_space(3)))
constexpr int BM = 256, BK = 64, HALF = 128, HTB = HALF * BK * 2, STAGE_BYTES = 8 * HTB, NXCD = 8, WGM = 8;
__host__ __device__ __forceinline__ int lds_byte(int r, int c) { const int st = (r >> 4) * 2 + (c >> 5), rr = r & 15, cc = c & 31, ob = rr * 64 + cc * 2; return st * 1024 + (ob ^ (((ob >> 9) & 1) << 5)); }
__host__ __device__ __forceinline__ void stage_rc(int b, int& R, int& C) { const int st = b / 1024, sb = b % 1024, swz = sb ^ (((sb >> 9) & 1) << 5); R = (st >> 1) * 16 + swz / 64; C = (st & 1) * 32 + (swz % 64) / 2; }
__host__ __device__ __forceinline__ int perm32(int rho) { const int n = rho >> 4, i = rho & 15; return 8 * (i >> 2) + 4 * n + (i & 3); }

struct Unit { int pm, pn, pass; };
struct Gemm { const bf16_t* A; const bf16_t* Bt; int lda, ldb, nt, kpass; unsigned gapA; int gapFrom; };

template <int NPASS> struct TileOrder {
    int nM, nN, nwg, G, c;
    __device__ void init(int M_, int N_, int G_, int c_) { nM = M_ / BM; nN = N_ / BM; nwg = nM * nN; G = G_; c = c_; }
    __device__ bool next(int i, Unit& u) const {
        const int ti = i / NPASS; u.pass = i % NPASS;
        const long L = (long)ti * G + c; if (L >= nwg) return false;
        int wgid = (int)L; { const int q = nwg / NXCD, r = nwg % NXCD, xcd = wgid % NXCD, off = wgid / NXCD; wgid = (xcd < r ? xcd * (q + 1) : r * (q + 1) + (xcd - r) * q) + off; }
        const int nig = WGM * nN, gid = wgid / nig, fm = gid * WGM, gsz = (nM - fm) < WGM ? (nM - fm) : WGM;
        u.pm = fm + ((wgid % nig) % gsz); u.pn = (wgid % nig) / gsz;
        u.pn = (u.pn + 4 * (int)(L % NXCD)) % nN;
        return true;
    }
};

__device__ __forceinline__ unsigned cvt_pk_bf16(float lo, float hi) { f32x2_t v = {lo, hi}; bf16x2_t b = __builtin_convertvector(v, bf16x2_t); return __builtin_bit_cast(unsigned, b); }
__device__ __forceinline__ u32x4 pack8(const f32x4 v0, const f32x4 v1) { u32x4 w; w.x = cvt_pk_bf16(v0[0], v0[1]); w.y = cvt_pk_bf16(v0[2], v0[3]); w.z = cvt_pk_bf16(v1[0], v1[1]); w.w = cvt_pk_bf16(v1[2], v1[3]); return w; }
__device__ __forceinline__ float fast_sigmoid(float x) { return __builtin_amdgcn_rcpf(1.0f + __builtin_amdgcn_exp2f(-1.4426950408889634f * x)); }

struct EpiZ {
    static constexpr bool PERM = true;
    struct Pre {}; __device__ __forceinline__ Pre prefetch(const Unit&, int, int, int, int) const { return Pre{}; }
    unsigned char* ws; const float* b_gate; const float* qna; const float* kna; const float* knb; PG8_LAS float* xch;
    __device__ __forceinline__ bool operator()(f32x4 (&acc)[2][2][4][2], const Unit& u, int wr, int wc, int fr, int fq, const Pre&) const {
        const int colt = u.pn * BM, row0 = u.pm * BM + wr * 64 + fr;
        if (colt >= C_KB && colt < C_VB) {
            float ssr[2][4];
#pragma unroll
            for (int ai = 0; ai < 2; ++ai)
#pragma unroll
                for (int m = 0; m < 4; ++m) { float ss = 0.f;
#pragma unroll
                    for (int bj = 0; bj < 2; ++bj)
#pragma unroll
                        for (int n = 0; n < 2; ++n) { const f32x4 v = acc[ai][bj][m][n]; ss += (v[0] * v[0] + v[1] * v[1]) + (v[2] * v[2] + v[3] * v[3]); }
                    ss += __shfl_xor(ss, 16); ss += __shfl_xor(ss, 32); ssr[ai][m] = ss;
                    if (fq == 0) xch[(wr * 4 + wc) * 128 + (ai * 4 + m) * 16 + fr] = ss; }
            asm volatile("s_waitcnt lgkmcnt(0)" ::: "memory"); __builtin_amdgcn_s_barrier(); asm volatile("" ::: "memory");
            const int d0 = 64 * (wc & 1) + 8 * fq;
            f32x4 gv[2][2];
#pragma unroll
            for (int bj = 0; bj < 2; ++bj)
#pragma unroll
                for (int n = 0; n < 2; ++n) gv[bj][n] = *(const f32x4*)(knb + d0 + 32 * bj + 4 * n);
            f32x4 cs[2][2];
#pragma unroll
            for (int bj = 0; bj < 2; ++bj)
#pragma unroll
                for (int n = 0; n < 2; ++n) cs[bj][n] = (f32x4){0.f, 0.f, 0.f, 0.f};
            bf16_t* base = (bf16_t*)(ws + WS_KB); const int col0 = (colt - C_KB) + wc * 64 + 8 * fq;
#pragma unroll
            for (int ai = 0; ai < 2; ++ai)
#pragma unroll
                for (int m = 0; m < 4; ++m) {
                    const float tot = ssr[ai][m] + xch[(wr * 4 + (wc ^ 1)) * 128 + (ai * 4 + m) * 16 + fr];
                    const float rs = rsqrtf(tot * (1.f / 128.f) + RMS_EPS);
                    bf16_t* rowp = base + (size_t)(row0 + ai * HALF + m * 16) * 1024 + col0;
#pragma unroll
                    for (int bj = 0; bj < 2; ++bj) { const f32x4 y0 = acc[ai][bj][m][0] * rs * gv[bj][0], y1 = acc[ai][bj][m][1] * rs * gv[bj][1];
                        cs[bj][0] += y0; cs[bj][1] += y1;
                        *(u32x4*)(rowp + bj * 32) = pack8(y0, y1); } }
            int* km = (int*)(ws + WS_KMEAN) + (size_t)u.pm * 1024 + col0;
#pragma unroll
            for (int bj = 0; bj < 2; ++bj)
#pragma unroll
                for (int n = 0; n < 2; ++n)
#pragma unroll
                    for (int e = 0; e < 4; ++e) { float v = cs[bj][n][e];
                        v += __shfl_xor(v, 1); v += __shfl_xor(v, 2); v += __shfl_xor(v, 4); v += __shfl_xor(v, 8);
                        if (fr == 0) atomicAdd(km + 32 * bj + 4 * n + e, __float2int_rn(v * 262144.f)); }
            return false;
        }
        bf16_t* base; int ldc, cl;
        if (colt < C_KA) { base = (bf16_t*)(ws + WS_QA); ldc = 1024; cl = colt - C_QA; }
        else if (colt < C_VA) { base = (bf16_t*)(ws + WS_KA); ldc = 256; cl = colt - C_KA; }
        else if (colt < C_QB) { base = (bf16_t*)(ws + WS_VA); ldc = 256; cl = colt - C_VA; }
        else if (colt < C_KB) { base = (bf16_t*)(ws + WS_QB); ldc = 1024; cl = colt - C_QB; }
        else if (colt < C_VB) { base = (bf16_t*)(ws + WS_KB); ldc = 1024; cl = colt - C_KB; }
        else if (colt < C_G) { base = (bf16_t*)(ws + WS_VB); ldc = 1024; cl = colt - C_VB; }
        else { base = (bf16_t*)(ws + WS_GATES); ldc = 4096; cl = colt - C_G; }
        const int col0 = cl + wc * 64 + 8 * fq;
        if (colt < C_VA) {
            const float* g = (colt < C_KA) ? qna : kna; const float sc = (colt < C_KA) ? SC_QA : 1.0f;
            f32x4 gv[2][2];
#pragma unroll
            for (int bj = 0; bj < 2; ++bj)
#pragma unroll
                for (int n = 0; n < 2; ++n) gv[bj][n] = *(const f32x4*)(g + 32 * bj + 8 * fq + 4 * n) * sc;
#pragma unroll
            for (int ai = 0; ai < 2; ++ai)
#pragma unroll
                for (int m = 0; m < 4; ++m) { bf16_t* rowp = base + (size_t)(row0 + ai * HALF + m * 16) * ldc + col0;
                    float ss = 0.f;
#pragma unroll
                    for (int bj = 0; bj < 2; ++bj)
#pragma unroll
                        for (int n = 0; n < 2; ++n) { const f32x4 v = acc[ai][bj][m][n]; ss += (v[0] * v[0] + v[1] * v[1]) + (v[2] * v[2] + v[3] * v[3]); }
                    ss += __shfl_xor(ss, 16); ss += __shfl_xor(ss, 32);
                    const float rs = rsqrtf(ss * (1.f / 64.f) + RMS_EPS);
#pragma unroll
                    for (int bj = 0; bj < 2; ++bj) *(u32x4*)(rowp + bj * 32) = pack8(acc[ai][bj][m][0] * rs * gv[bj][0], acc[ai][bj][m][1] * rs * gv[bj][1]); }
        } else if (colt < C_G) {
#pragma unroll
            for (int ai = 0; ai < 2; ++ai)
#pragma unroll
                for (int m = 0; m < 4; ++m) { bf16_t* rowp = base + (size_t)(row0 + ai * HALF + m * 16) * ldc + col0;
#pragma unroll
                    for (int bj = 0; bj < 2; ++bj) *(u32x4*)(rowp + bj * 32) = pack8(acc[ai][bj][m][0], acc[ai][bj][m][1]); }
        } else {
            const int mc0 = ((colt - C_G) >> 1) + wc * 32 + 8 * fq;
            f32x4 ba[2], bb[2];
#pragma unroll
            for (int n = 0; n < 2; ++n) { ba[n] = *(const f32x4*)(b_gate + mc0 + 4 * n); bb[n] = *(const f32x4*)(b_gate + 2048 + mc0 + 4 * n); }
#pragma unroll
            for (int ai = 0; ai < 2; ++ai)
#pragma unroll
                for (int m = 0; m < 4; ++m) { bf16_t* rowp = (bf16_t*)(ws + WS_GATES) + (size_t)(row0 + ai * HALF + m * 16) * 4096 + mc0;
                    f32x4 r0, r1, g0, g1;
#pragma unroll
                    for (int e = 0; e < 4; ++e) {
                        const float ea0 = __builtin_amdgcn_exp2f(-1.4426950408889634f * (acc[ai][0][m][0][e] + ba[0][e])), ea1 = __builtin_amdgcn_exp2f(-1.4426950408889634f * (acc[ai][0][m][1][e] + ba[1][e]));
                        const float eb0 = __builtin_amdgcn_exp2f(-1.4426950408889634f * (acc[ai][1][m][0][e] + bb[0][e])), eb1 = __builtin_amdgcn_exp2f(-1.4426950408889634f * (acc[ai][1][m][1][e] + bb[1][e]));
                        g0[e] = __builtin_amdgcn_rcpf(1.0f + eb0); g1[e] = __builtin_amdgcn_rcpf(1.0f + eb1);
                        r0[e] = (1.0f + eb0) * __builtin_amdgcn_rcpf(1.0f + ea0); r1[e] = (1.0f + eb1) * __builtin_amdgcn_rcpf(1.0f + ea1);
                    }
                    *(u32x4*)(rowp) = pack8(r0, r1); *(u32x4*)(rowp + 2048) = pack8(g0, g1); }
        }
        return false;
    }
};
struct EpiMixed {
    static constexpr bool PERM = true;
    struct Pre {}; __device__ __forceinline__ Pre prefetch(const Unit&, int, int, int, int) const { return Pre{}; }
    const bf16_t* G; bf16_t* MX;
    __device__ __forceinline__ bool operator()(f32x4 (&acc)[2][2][4][2], const Unit& u, int wr, int wc, int fr, int fq, const Pre&) const {
        const int row0 = u.pm * BM + wr * 64 + fr, col0 = u.pn * BM + wc * 64 + 8 * fq;
#pragma unroll
        for (int ai = 0; ai < 2; ++ai)
#pragma unroll
            for (int m = 0; m < 4; ++m) { const size_t row = (size_t)(row0 + ai * HALF + m * 16);
#pragma unroll
                for (int bj = 0; bj < 2; ++bj) { const int col = col0 + bj * 32;
                    const u32x4 gw = *(const u32x4*)(G + row * 4096 + (u.pass == 0 ? 0 : 2048) + col);
                    float gg[8]; unpack8(gw, gg);
                    if (u.pass == 0) {
#pragma unroll
                        for (int e = 0; e < 4; ++e) { acc[ai][bj][m][0][e] *= gg[e]; acc[ai][bj][m][1][e] *= gg[4 + e]; }
                    } else {
                        f32x4 v0, v1;
#pragma unroll
                        for (int e = 0; e < 4; ++e) { v0[e] = acc[ai][bj][m][0][e] * gg[e]; v1[e] = acc[ai][bj][m][1][e] * gg[4 + e]; }
                        *(u32x4*)(MX + row * 4096 + col) = pack8(v0, v1);
                    } } }
        return u.pass == 0;
    }
};
struct EpiWo {
    static constexpr bool PERM = true;
    struct Pre {}; __device__ __forceinline__ Pre prefetch(const Unit&, int, int, int, int) const { return Pre{}; }
    const float* x; float* out; bf16_t* H1B; float* sumsq;
    __device__ __forceinline__ bool operator()(f32x4 (&acc)[2][2][4][2], const Unit& u, int wr, int wc, int fr, int fq, const Pre&) const {
        const int row0 = u.pm * BM + wr * 64 + fr, col0 = u.pn * BM + wc * 64 + 8 * fq;
#pragma unroll
        for (int ai = 0; ai < 2; ++ai)
#pragma unroll
            for (int m = 0; m < 4; ++m) { const int row = row0 + ai * HALF + m * 16; const size_t off = (size_t)row * DM + col0; float ss = 0.f;
#pragma unroll
                for (int bj = 0; bj < 2; ++bj) { const size_t o = off + bj * 32;
                    const f32x4 h0 = *(const f32x4*)(x + o) + acc[ai][bj][m][0], h1 = *(const f32x4*)(x + o + 4) + acc[ai][bj][m][1];
                    *(u32x4*)(H1B + o) = pack8(h0, h1);
                    ss += ((h0[0] * h0[0] + h0[1] * h0[1]) + (h0[2] * h0[2] + h0[3] * h0[3])) + ((h1[0] * h1[0] + h1[1] * h1[1]) + (h1[2] * h1[2] + h1[3] * h1[3])); }
                ss += __shfl_xor(ss, 16); ss += __shfl_xor(ss, 32);
                if (fq == 0) atomicAdd(sumsq + row, ss);
                if (m & 1) asm volatile("" ::: "memory"); }
        return false;
    }
};
struct EpiSwiglu {
    static constexpr bool PERM = true;
    const float* sumsq; bf16_t* ACT;
    struct Pre { float ss[2][4]; };
    __device__ __forceinline__ Pre prefetch(const Unit& u, int wr, int wc, int fr, int fq) const { Pre r; const int row0 = u.pm * BM + wr * 64 + fr;
#pragma unroll
        for (int ai = 0; ai < 2; ++ai)
#pragma unroll
            for (int m = 0; m < 4; ++m) r.ss[ai][m] = sumsq[row0 + ai * HALF + m * 16];
        return r; }
    __device__ __forceinline__ bool operator()(f32x4 (&acc)[2][2][4][2], const Unit& u, int wr, int wc, int fr, int fq, const Pre& pre) const {
        const int row0 = u.pm * BM + wr * 64 + fr, acol0 = u.pn * HALF + wc * 32 + 8 * fq;
#pragma unroll
        for (int ai = 0; ai < 2; ++ai)
#pragma unroll
            for (int m = 0; m < 4; ++m) { const int row = row0 + ai * HALF + m * 16;
                const float rstd = rsqrtf(pre.ss[ai][m] * (1.f / DM) + RMS_EPS);
                f32x4 a0, a1;
#pragma unroll
                for (int e = 0; e < 4; ++e) { const float g0 = acc[ai][0][m][0][e] * rstd, g1 = acc[ai][0][m][1][e] * rstd;
                    a0[e] = g0 * fast_sigmoid(g0) * (acc[ai][1][m][0][e] * rstd); a1[e] = g1 * fast_sigmoid(g1) * (acc[ai][1][m][1][e] * rstd); }
                *(u32x4*)(ACT + (size_t)row * DFF + acol0 + (u.pm >= ACT_GAP_FROM ? ACT_GAP / 2 : (size_t)0)) = pack8(a0, a1); }
        return false;
    }
};
struct EpiDown {
    static constexpr bool PERM = true;
    struct Pre {}; __device__ __forceinline__ Pre prefetch(const Unit&, int, int, int, int) const { return Pre{}; }
    float* out; const bf16_t* H1B;
    __device__ __forceinline__ bool operator()(f32x4 (&acc)[2][2][4][2], const Unit& u, int wr, int wc, int fr, int fq, const Pre&) const {
        const int row0 = u.pm * BM + wr * 64 + fr, col0 = u.pn * BM + wc * 64 + 8 * fq;
#pragma unroll
        for (int ai = 0; ai < 2; ++ai)
#pragma unroll
            for (int m = 0; m < 4; ++m) { const size_t off = (size_t)(row0 + ai * HALF + m * 16) * DM + col0;
#pragma unroll
                for (int bj = 0; bj < 2; ++bj) { const size_t o = off + bj * 32; const u32x4 w = *(const u32x4*)(H1B + o);
                    *(f32x4*)(out + o) = (f32x4){bflo(w.x), bfhi(w.x), bflo(w.y), bfhi(w.y)} + acc[ai][bj][m][0];
                    *(f32x4*)(out + o + 4) = (f32x4){bflo(w.z), bfhi(w.z), bflo(w.w), bfhi(w.w)} + acc[ai][bj][m][1]; }
                if (m & 1) asm volatile("" ::: "memory"); }
        return false;
    }
};

template <class Epi, class Sched>
__device__ __forceinline__ void gemm_phase(PG8_LAS unsigned char* lds, const Gemm g, const Sched& S, const Epi& E) {
    const int tid = opaque_tid(), wid = __builtin_amdgcn_readfirstlane(tid >> 6), lane = tid & 63, wr = wid >> 2, wc = wid & 3, fr = lane & 15, fq = lane >> 4;
    const int nt = g.nt;
    unsigned voffA[2], voffB[2];
#pragma unroll
    for (int i = 0; i < 2; ++i) { int R, C; stage_rc(tid * 16 + i * 8192, R, C); const int Rb = Epi::PERM ? ((R & ~31) + perm32(R & 31)) : R;
        voffA[i] = (unsigned)(R * g.lda + C) * 2u; voffB[i] = (unsigned)(Rb * g.ldb + C) * 2u; }
    const unsigned kstep = (unsigned)(BK * 2);
    const unsigned hstepA = (unsigned)HALF * g.lda * 2, hstepB = (unsigned)HALF * g.ldb * 2;
    const unsigned tstepA = 2 * hstepA, tstepB = 2 * hstepB;
    const __amdgpu_buffer_rsrc_t rsA = __builtin_amdgcn_make_buffer_rsrc((void*)g.A, 0, -1, 0x00020000);
    const __amdgpu_buffer_rsrc_t rsB = __builtin_amdgcn_make_buffer_rsrc((void*)g.Bt, 0, -1, 0x00020000);
    const unsigned ldsw = (unsigned)wid * 1024u;
    const int aoff = lds_byte(wr * 64 + fr, fq * 8), boff = lds_byte(wc * 32 + fr, fq * 8);
#define PG8_SA(b, h) (((b) * 2 + (h)) * HTB)
#define PG8_SB(b, h) ((4 + (b) * 2 + (h)) * HTB)
#define PG8_STAGE(bufoff, rs, soff, voff) do { _Pragma("unroll") for (int _i = 0; _i < 2; ++_i) \
        __builtin_amdgcn_raw_ptr_buffer_load_lds(rs, (PG8_LAS unsigned*)(lds + (bufoff) + ldsw + _i * 8192), 16, (int)(voff)[_i], (int)(soff), 0, 0); } while (0)
#define PG8_LDA(dst, b, h) do { _Pragma("unroll") for (int m = 0; m < 4; ++m) _Pragma("unroll") for (int k = 0; k < 2; ++k) dst[m][k] = *(const PG8_LAS bf16x8*)(lds + PG8_SA(b, h) + aoff + m * 2048 + k * 1024); } while (0)
#define PG8_LDB(dst, b, h) do { _Pragma("unroll") for (int n = 0; n < 2; ++n) _Pragma("unroll") for (int k = 0; k < 2; ++k) dst[n][k] = *(const PG8_LAS bf16x8*)(lds + PG8_SB(b, h) + boff + n * 2048 + k * 1024); } while (0)
#define PG8_MMA(ai, bj, At, Bt) do { __builtin_amdgcn_s_setprio(1); _Pragma("unroll") for (int m = 0; m < 4; ++m) _Pragma("unroll") for (int n = 0; n < 2; ++n) _Pragma("unroll") for (int k = 0; k < 2; ++k) \
        acc[ai][bj][m][n] = __builtin_amdgcn_mfma_f32_16x16x32_bf16(Bt[n][k], At[m][k], acc[ai][bj][m][n], 0, 0, 0); __builtin_amdgcn_s_setprio(0); } while (0)
#define PG8_WAIT_V(n) asm volatile("s_waitcnt vmcnt(" #n ")" ::: "memory")
#define PG8_WAIT_L(n) asm volatile("s_waitcnt lgkmcnt(" #n ")" ::: "memory")
#define PG8_BAR __builtin_amdgcn_s_barrier()
#define PG8_SCHED __builtin_amdgcn_sched_barrier(0)
    Unit cur, nxt; int ui = 0;
    if (!S.next(0, cur)) return;
    f32x4 acc[2][2][4][2];
#pragma unroll
    for (int a = 0; a < 2; ++a)
#pragma unroll
        for (int b = 0; b < 2; ++b)
#pragma unroll
            for (int m = 0; m < 4; ++m)
#pragma unroll
                for (int n = 0; n < 2; ++n) acc[a][b][m][n] = (f32x4){0.f, 0.f, 0.f, 0.f};
    bf16x8 At[4][2], B0[2][2], B1[2][2];
    typename Epi::Pre pre = E.prefetch(cur, wr, wc, fr, fq);
    unsigned cA = (unsigned)cur.pm * tstepA + (unsigned)cur.pass * g.kpass * 2 + (cur.pm >= g.gapFrom ? g.gapA : 0u), cB = (unsigned)cur.pn * tstepB + (unsigned)cur.pass * g.kpass * 2;
    PG8_STAGE(PG8_SB(0, 0), rsB, cB, voffB); PG8_STAGE(PG8_SB(0, 1), rsB, cB + hstepB, voffB); PG8_STAGE(PG8_SA(0, 0), rsA, cA, voffA); PG8_STAGE(PG8_SA(0, 1), rsA, cA + hstepA, voffA);
    if (wr == 1) PG8_BAR;
    PG8_WAIT_V(2); PG8_BAR;
    PG8_STAGE(PG8_SB(1, 0), rsB, cB + kstep, voffB); PG8_STAGE(PG8_SA(1, 0), rsA, cA + kstep, voffA); PG8_STAGE(PG8_SB(1, 1), rsB, cB + hstepB + kstep, voffB);
    PG8_WAIT_V(6); PG8_BAR;
    for (;;) {
        const bool has_next = S.next(ui + 1, nxt);
        const unsigned nA = has_next ? (unsigned)nxt.pm * tstepA + (unsigned)nxt.pass * g.kpass * 2 + (nxt.pm >= g.gapFrom ? g.gapA : 0u) : cA;
        const unsigned nB = has_next ? (unsigned)nxt.pn * tstepB + (unsigned)nxt.pass * g.kpass * 2 : cB;
        for (int t = 0; t < nt; t += 2) {
            const bool last = (t == nt - 2);
            const unsigned a1 = cA + (unsigned)(t + 1) * kstep;
            const unsigned a2 = last ? nA : cA + (unsigned)(t + 2) * kstep, b2 = last ? nB : cB + (unsigned)(t + 2) * kstep;
            const unsigned a3 = a2 + kstep, b3 = b2 + kstep;
            PG8_LDB(B0, 0, 0); PG8_LDB(B1, 0, 1); PG8_SCHED; PG8_LDA(At, 0, 0); PG8_STAGE(PG8_SA(1, 1), rsA, a1 + hstepA, voffA);
            PG8_WAIT_V(8); PG8_WAIT_L(0); PG8_BAR; PG8_MMA(0, 0, At, B0); PG8_MMA(0, 1, At, B1); PG8_BAR; PG8_SCHED;
            PG8_LDA(At, 0, 1); PG8_STAGE(PG8_SB(0, 0), rsB, b2, voffB); PG8_STAGE(PG8_SB(0, 1), rsB, b2 + hstepB, voffB); PG8_STAGE(PG8_SA(0, 0), rsA, a2, voffA);
            PG8_WAIT_V(8); PG8_WAIT_L(0); PG8_BAR; PG8_MMA(1, 0, At, B0); PG8_MMA(1, 1, At, B1); PG8_BAR; PG8_SCHED;
            PG8_LDB(B0, 1, 0); PG8_LDB(B1, 1, 1); PG8_SCHED; PG8_LDA(At, 1, 0); PG8_STAGE(PG8_SA(0, 1), rsA, a2 + hstepA, voffA);
            PG8_WAIT_V(8); PG8_WAIT_L(0); PG8_BAR; PG8_MMA(0, 0, At, B0); PG8_MMA(0, 1, At, B1); PG8_BAR; PG8_SCHED;
            PG8_LDA(At, 1, 1); PG8_STAGE(PG8_SB(1, 0), rsB, b3, voffB); PG8_STAGE(PG8_SB(1, 1), rsB, b3 + hstepB, voffB); PG8_STAGE(PG8_SA(1, 0), rsA, a3, voffA);
            PG8_WAIT_V(8); PG8_WAIT_L(0); PG8_BAR; PG8_MMA(1, 0, At, B0); PG8_MMA(1, 1, At, B1); PG8_BAR; PG8_SCHED;
        }
        if (wr == 0) PG8_BAR;
        const bool keep = E(acc, cur, wr, wc, fr, fq, pre);
        if (has_next) pre = E.prefetch(nxt, wr, wc, fr, fq);
        if (!has_next) break;
        if (!keep) {
#pragma unroll
            for (int a = 0; a < 2; ++a)
#pragma unroll
                for (int b = 0; b < 2; ++b)
#pragma unroll
                    for (int m = 0; m < 4; ++m)
#pragma unroll
                        for (int n = 0; n < 2; ++n) acc[a][b][m][n] = (f32x4){0.f, 0.f, 0.f, 0.f};
        }
        cur = nxt; cA = nA; cB = nB; ++ui;
        if (wr == 1) PG8_BAR;
    }
    PG8_WAIT_V(0);
    PG8_BAR;
#undef PG8_SA
#undef PG8_SB
#undef PG8_STAGE
#undef PG8_LDA
#undef PG8_LDB
#undef PG8_MMA
#undef PG8_WAIT_V
#undef PG8_WAIT_L
#undef PG8_BAR
#undef PG8_SCHED
}
}

namespace att {
#define ATT_LAS __attribute__((address_space(3)))
typedef float f32x16 __attribute__((ext_vector_type(16)));
typedef short s16x4 __attribute__((ext_vector_type(4)));
constexpr float NEG = -1.0e30f;
constexpr float SHIFT = 12.0f;
template <int D> struct Cfg {
    static constexpr int KP = D * 2 + 16;
    static constexpr int VP = (D == 128) ? 320 : 192;
    static constexpr int KBYTES = 64 * KP, VBYTES = 64 * VP, STG = KBYTES + VBYTES;
    static constexpr int NKS = D / 16, NDB = D / 32, NCH = D / 8, PPT = (64 * NCH) / NTHREADS;
};
__device__ __forceinline__ s16x4 vtr(const ATT_LAS unsigned char* p) { return __builtin_bit_cast(s16x4, __builtin_amdgcn_ds_read_tr16_b64_v4i16((ATT_LAS s16x4*)p)); }

template <int D, bool MOBA>
__device__ __forceinline__ void attn_unit(ATT_LAS unsigned char* lds, const Params& p, int b, int hg, int blk) {
    typedef Cfg<D> C;
    const int tid = opaque_tid(), lane = tid & 63, wave = __builtin_amdgcn_readfirstlane(tid >> 6), q = lane & 31, hi = lane >> 5;
    unsigned char* ws = p.ws;
    const int seqbase = b * SEQ;
    const int qpos0 = MOBA ? 256 * blk : 64 * blk;
    const int t = MOBA ? qpos0 + 32 * wave + q : qpos0 + 32 * (wave & 1) + q;
    const int head = MOBA ? hg : 4 * hg + (wave >> 1);
    const size_t row = (size_t)(seqbase + t);
    const bf16_t* Qrow = MOBA ? (const bf16_t*)(ws + WS_QB) + row * 1024 + head * 128 : (const bf16_t*)(ws + WS_QA) + row * 1024 + head * 64;
    const int kvpitch = MOBA ? 1024 : 256;
    const bf16_t* Kp = (MOBA ? (const bf16_t*)(ws + WS_KB) : (const bf16_t*)(ws + WS_KA)) + (size_t)seqbase * kvpitch + hg * D;
    const bf16_t* Vp = (MOBA ? (const bf16_t*)(ws + WS_VB) : (const bf16_t*)(ws + WS_VA)) + (size_t)seqbase * kvpitch + hg * D;
    bf16_t* Orow = (bf16_t*)(ws + WS_XN) + row * 2048 + (MOBA ? 1024 + head * 128 : head * 64);
    const float slope2 = (MOBA ? exp2f(-(float)(head + 1)) : exp2f(-0.5f * (float)(head + 1))) * LOG2E;

    bf16x8 qf[C::NKS];
#pragma unroll
    for (int ks = 0; ks < C::NKS; ++ks) qf[ks] = *(const bf16x8*)(Qrow + 16 * ks + 8 * hi);

    if constexpr (MOBA) {
        float ssq = 0.f;
#pragma unroll
        for (int ks = 0; ks < C::NKS; ++ks) { float f[8]; unpack8(__builtin_bit_cast(u32x4, qf[ks]), f);
#pragma unroll
            for (int j = 0; j < 8; ++j) ssq += f[j] * f[j]; }
        ssq += __shfl_xor(ssq, 32);
        const float rs = rsqrtf(ssq * (1.f / 128.f) + RMS_EPS) * SC_QB;
#pragma unroll
        for (int ks = 0; ks < C::NKS; ++ks) { float f[8]; unpack8(__builtin_bit_cast(u32x4, qf[ks]), f);
            const f32x4 g0 = *(const f32x4*)(p.qnb + 16 * ks + 8 * hi), g1 = *(const f32x4*)(p.qnb + 16 * ks + 8 * hi + 4);
            u32x4 w; w.x = pg8::cvt_pk_bf16(f[0] * rs * g0[0], f[1] * rs * g0[1]); w.y = pg8::cvt_pk_bf16(f[2] * rs * g0[2], f[3] * rs * g0[3]);
            w.z = pg8::cvt_pk_bf16(f[4] * rs * g1[0], f[5] * rs * g1[1]); w.w = pg8::cvt_pk_bf16(f[6] * rs * g1[2], f[7] * rs * g1[3]);
            qf[ks] = __builtin_bit_cast(bf16x8, w); }
    }
    unsigned selbits = 0u;
    if constexpr (MOBA) {
        if (blk > 0) {
            const int* kmean = (const int*)(ws + WS_KMEAN) + (size_t)(b * 8) * 1024 + head * 128 + 8 * hi;
            float gt[8];
#pragma unroll
            for (int n = 0; n < 7; ++n) {
                float g = -INFINITY;
                if (n < blk) {
                    float part = 0.f;
#pragma unroll
                    for (int ks = 0; ks < 8; ++ks) {
                        const int4 k0 = *(const int4*)(kmean + n * 1024 + 16 * ks), k1 = *(const int4*)(kmean + n * 1024 + 16 * ks + 4);
                        const u32x4 qw = __builtin_bit_cast(u32x4, qf[ks]);
                        part += bflo(qw.x) * (float)k0.x + bfhi(qw.x) * (float)k0.y + bflo(qw.y) * (float)k0.z + bfhi(qw.y) * (float)k0.w
                              + bflo(qw.z) * (float)k1.x + bfhi(qw.z) * (float)k1.y + bflo(qw.w) * (float)k1.z + bfhi(qw.w) * (float)k1.w;
                    }
                    g = part + __shfl_xor(part, 32);
                }
                gt[n] = g;
            }
            gt[7] = -INFINITY;
#pragma unroll
            for (int n = 0; n < 7; ++n) {
                int rank = 0;
#pragma unroll
                for (int n2 = 0; n2 < 7; ++n2) if (n2 != n) rank += (n2 < blk && (gt[n2] > gt[n] || (gt[n2] == gt[n] && n2 < n))) ? 1 : 0;
                if (n < blk && rank < 3) selbits |= (1u << n);
            }
        }
    }

    f32x16 O[C::NDB];
#pragma unroll
    for (int db = 0; db < C::NDB; ++db)
#pragma unroll
        for (int r = 0; r < 16; ++r) O[db][r] = 0.f;
    float l = 0.f;

    const int T = MOBA ? 4 * (blk + 1) : (blk >= 2 ? 3 : blk + 1);
#define ATT_KPOS(i) (MOBA ? ((i) < 4 ? 256 * blk + 64 * (i) : 256 * (((i) - 4) >> 2) + 64 * (((i) - 4) & 3)) : qpos0 - 64 * (i))
    u32x4 kreg[C::PPT], vreg[C::PPT];
    const int prow = tid / C::NCH, pch = tid % C::NCH;
    const unsigned goff = (unsigned)(prow * kvpitch + pch * 8) * 2u;
    const int lk = C::KP * prow + 16 * pch, lv = C::KBYTES + C::VP * prow + 16 * pch;
    constexpr int PR = NTHREADS / C::NCH;
#define ATT_LOAD(kp0) do { const char* _kt = (const char*)(Kp + (size_t)(kp0) * kvpitch); const char* _vt = (const char*)(Vp + (size_t)(kp0) * kvpitch); \
        _Pragma("unroll") for (int _i = 0; _i < C::PPT; ++_i) { kreg[_i] = *(const u32x4*)(_kt + (size_t)_i * PR * kvpitch * 2 + goff); vreg[_i] = *(const u32x4*)(_vt + (size_t)_i * PR * kvpitch * 2 + goff); } } while (0)
#define ATT_WRITE(buf) do { _Pragma("unroll") for (int _i = 0; _i < C::PPT; ++_i) { \
        *(ATT_LAS u32x4*)(lds + (buf) * C::STG + lk + _i * PR * C::KP) = kreg[_i]; *(ATT_LAS u32x4*)(lds + (buf) * C::STG + lv + _i * PR * C::VP) = vreg[_i]; } } while (0)
    const int ka = C::KP * q + 16 * hi;
    const int va = C::VP * (4 * hi + ((lane & 15) >> 2)) + 32 * ((lane >> 4) & 1) + 8 * (lane & 3);
    ATT_LOAD(ATT_KPOS(0)); ATT_WRITE(0); if (T > 1) ATT_LOAD(ATT_KPOS(1)); __syncthreads();
    const int TA = MOBA ? 0 : T;
    for (int i = 0; i < TA; ++i) {
        if (i + 1 < T) ATT_WRITE((i + 1) & 1);
        if (i + 2 < T) ATT_LOAD(ATT_KPOS(i + 2));
        const int kp0 = ATT_KPOS(i);
        int klo = 0, khi = 63;
        if constexpr (MOBA) { khi = t - kp0; }
        else { if (i == 0) khi = t - kp0; if (i == 2) klo = t - 127 - kp0; }
        if (khi > 63) khi = 63; if (klo < 0) klo = 0;
        const bool anyvalid = (khi >= klo);
        if (__any(anyvalid)) {
            const float lbase = slope2 * (float)(kp0 + 4 * hi - t) - SHIFT;
#pragma unroll 1
            for (int hf = 0; hf < 2; ++hf) {
                if (!__any(anyvalid && klo <= 32 * hf + 31 && khi >= 32 * hf)) continue;
                const bool allfull = __all(!anyvalid || (klo <= 32 * hf && khi >= 32 * hf + 31));
                const ATT_LAS unsigned char* Kt = lds + (i & 1) * C::STG + hf * 32 * C::KP;
                const ATT_LAS unsigned char* Vt = lds + (i & 1) * C::STG + C::KBYTES + hf * 32 * C::VP;
                const float lb = anyvalid ? lbase + (float)(32 * hf) * slope2 : NEG;
                f32x16 s;
                if (allfull) {
#pragma unroll
                    for (int r = 0; r < 16; ++r) s[r] = __builtin_fmaf(slope2, (float)((r & 3) + 8 * (r >> 2)), lb);
                } else {
#pragma unroll
                    for (int r = 0; r < 16; ++r) { const int ko = 32 * hf + 4 * hi + (r & 3) + 8 * (r >> 2);
                        s[r] = (ko >= klo && ko <= khi) ? __builtin_fmaf(slope2, (float)((r & 3) + 8 * (r >> 2)), lb) : NEG; }
                }
#pragma unroll
                for (int ks = 0; ks < C::NKS; ++ks) s = __builtin_amdgcn_mfma_f32_32x32x16_bf16(*(const ATT_LAS bf16x8*)(Kt + ka + 32 * ks), qf[ks], s, 0, 0, 0);
                float ls0 = 0.f, ls1 = 0.f, ls2 = 0.f, ls3 = 0.f;
#pragma unroll
                for (int r = 0; r < 16; r += 4) { s[r] = __builtin_amdgcn_exp2f(s[r]); s[r + 1] = __builtin_amdgcn_exp2f(s[r + 1]); s[r + 2] = __builtin_amdgcn_exp2f(s[r + 2]); s[r + 3] = __builtin_amdgcn_exp2f(s[r + 3]);
                    ls0 += s[r]; ls1 += s[r + 1]; ls2 += s[r + 2]; ls3 += s[r + 3]; }
                l += (ls0 + ls1) + (ls2 + ls3);
                bf16x8 pf[2];
#pragma unroll
                for (int ss = 0; ss < 2; ++ss) {
                    u32x4 w;
                    w.x = pg8::cvt_pk_bf16(s[8 * ss + 0], s[8 * ss + 1]); w.y = pg8::cvt_pk_bf16(s[8 * ss + 2], s[8 * ss + 3]); w.z = pg8::cvt_pk_bf16(s[8 * ss + 4], s[8 * ss + 5]); w.w = pg8::cvt_pk_bf16(s[8 * ss + 6], s[8 * ss + 7]);
                    pf[ss] = __builtin_bit_cast(bf16x8, w);
                }
#pragma unroll
                for (int db = 0; db < C::NDB; ++db)
#pragma unroll
                    for (int ss = 0; ss < 2; ++ss) {
                        const s16x4 lo = vtr(Vt + va + 64 * db + C::VP * (16 * ss)), hh = vtr(Vt + va + 64 * db + C::VP * (16 * ss + 8));
                        const bf16x8 vf = (bf16x8){lo[0], lo[1], lo[2], lo[3], hh[0], hh[1], hh[2], hh[3]};
                        O[db] = __builtin_amdgcn_mfma_f32_32x32x16_bf16(vf, pf[ss], O[db], 0, 0, 0);
                    }
            }
        }
        __syncthreads();
    }
    if constexpr (MOBA) {
        auto moba_step = [&](const int i, auto own_tag) __attribute__((always_inline)) {
            constexpr bool OWN = decltype(own_tag)::value;

        if (i + 1 < T) ATT_WRITE((i + 1) & 1);
        if (i + 2 < T) ATT_LOAD(ATT_KPOS(i + 2));
        const int kp0 = ATT_KPOS(i);
        const int khi = t - kp0;
        const bool rowsel = OWN ? (khi >= 0) : (((selbits >> ((i - 4) >> 2)) & 1u) != 0u);
        if (__any(rowsel)) {
            const float lbv = rowsel ? slope2 * (float)(kp0 + 4 * hi - t) - SHIFT : NEG;
            const ATT_LAS unsigned char* Kt = lds + (i & 1) * C::STG;
            const ATT_LAS unsigned char* Vt = lds + (i & 1) * C::STG + C::KBYTES;
            f32x16 s0, s1;
#pragma unroll
            for (int r = 0; r < 16; ++r) { const float cr = (float)((r & 3) + 8 * (r >> 2)); s0[r] = __builtin_fmaf(slope2, cr, lbv); s1[r] = __builtin_fmaf(slope2, cr + 32.f, lbv); }
            if constexpr (OWN) {
#pragma unroll
                for (int r = 0; r < 16; ++r) { const int d0 = khi - (4 * hi + (r & 3) + 8 * (r >> 2));
                    s0[r] += __builtin_bit_cast(float, (d0 >> 31) & 0xF149F2CA);
                    s1[r] += __builtin_bit_cast(float, ((d0 - 32) >> 31) & 0xF149F2CA); }
            }
#pragma unroll
            for (int ks = 0; ks < C::NKS; ++ks) s0 = __builtin_amdgcn_mfma_f32_32x32x16_bf16(*(const ATT_LAS bf16x8*)(Kt + ka + 32 * ks), qf[ks], s0, 0, 0, 0);
            __builtin_amdgcn_sched_barrier(0);
            bf16x8 pf0[2], pf1[2];
            {
#pragma unroll
                for (int ks = 0; ks < C::NKS; ++ks) s1 = __builtin_amdgcn_mfma_f32_32x32x16_bf16(*(const ATT_LAS bf16x8*)(Kt + 32 * C::KP + ka + 32 * ks), qf[ks], s1, 0, 0, 0);
                float ls0 = 0.f, ls1 = 0.f, ls2 = 0.f, ls3 = 0.f;
#pragma unroll
                for (int r = 0; r < 16; r += 4) { s0[r] = __builtin_amdgcn_exp2f(s0[r]); s0[r + 1] = __builtin_amdgcn_exp2f(s0[r + 1]); s0[r + 2] = __builtin_amdgcn_exp2f(s0[r + 2]); s0[r + 3] = __builtin_amdgcn_exp2f(s0[r + 3]);
                    ls0 += s0[r]; ls1 += s0[r + 1]; ls2 += s0[r + 2]; ls3 += s0[r + 3]; }
                l += (ls0 + ls1) + (ls2 + ls3);
#pragma unroll
                for (int ss = 0; ss < 2; ++ss) { u32x4 w;
                    w.x = pg8::cvt_pk_bf16(s0[8 * ss + 0], s0[8 * ss + 1]); w.y = pg8::cvt_pk_bf16(s0[8 * ss + 2], s0[8 * ss + 3]); w.z = pg8::cvt_pk_bf16(s0[8 * ss + 4], s0[8 * ss + 5]); w.w = pg8::cvt_pk_bf16(s0[8 * ss + 6], s0[8 * ss + 7]);
                    pf0[ss] = __builtin_bit_cast(bf16x8, w); }
            }
            __builtin_amdgcn_sched_barrier(0);
            {
#pragma unroll
                for (int db = 0; db < C::NDB; ++db)
#pragma unroll
                    for (int ss = 0; ss < 2; ++ss) {
                        const s16x4 lo = vtr(Vt + va + 64 * db + C::VP * (16 * ss)), hh = vtr(Vt + va + 64 * db + C::VP * (16 * ss + 8));
                        const bf16x8 vf = (bf16x8){lo[0], lo[1], lo[2], lo[3], hh[0], hh[1], hh[2], hh[3]};
                        O[db] = __builtin_amdgcn_mfma_f32_32x32x16_bf16(vf, pf0[ss], O[db], 0, 0, 0);
                    }
                float ls0 = 0.f, ls1 = 0.f, ls2 = 0.f, ls3 = 0.f;
#pragma unroll
                for (int r = 0; r < 16; r += 4) { s1[r] = __builtin_amdgcn_exp2f(s1[r]); s1[r + 1] = __builtin_amdgcn_exp2f(s1[r + 1]); s1[r + 2] = __builtin_amdgcn_exp2f(s1[r + 2]); s1[r + 3] = __builtin_amdgcn_exp2f(s1[r + 3]);
                    ls0 += s1[r]; ls1 += s1[r + 1]; ls2 += s1[r + 2]; ls3 += s1[r + 3]; }
                l += (ls0 + ls1) + (ls2 + ls3);
#pragma unroll
                for (int ss = 0; ss < 2; ++ss) { u32x4 w;
                    w.x = pg8::cvt_pk_bf16(s1[8 * ss + 0], s1[8 * ss + 1]); w.y = pg8::cvt_pk_bf16(s1[8 * ss + 2], s1[8 * ss + 3]); w.z = pg8::cvt_pk_bf16(s1[8 * ss + 4], s1[8 * ss + 5]); w.w = pg8::cvt_pk_bf16(s1[8 * ss + 6], s1[8 * ss + 7]);
                    pf1[ss] = __builtin_bit_cast(bf16x8, w); }
            }
            __builtin_amdgcn_sched_barrier(0);
#pragma unroll
            for (int db = 0; db < C::NDB; ++db)
#pragma unroll
                for (int ss = 0; ss < 2; ++ss) {
                    const s16x4 lo = vtr(Vt + 32 * C::VP + va + 64 * db + C::VP * (16 * ss)), hh = vtr(Vt + 32 * C::VP + va + 64 * db + C::VP * (16 * ss + 8));
                    const bf16x8 vf = (bf16x8){lo[0], lo[1], lo[2], lo[3], hh[0], hh[1], hh[2], hh[3]};
                    O[db] = __builtin_amdgcn_mfma_f32_32x32x16_bf16(vf, pf1[ss], O[db], 0, 0, 0);
                }
            __builtin_amdgcn_sched_barrier(0);
        }
        __syncthreads();
            };
        for (int i = 0; i < 4; ++i) moba_step(i, std::true_type{});
        for (int i = 4; i < T; ++i) moba_step(i, std::false_type{});
    }
#undef ATT_KPOS
#undef ATT_LOAD
#undef ATT_WRITE
    float lt = l + __shfl_xor(l, 32);
    if constexpr (!MOBA) lt += __builtin_amdgcn_exp2f(p.sinks[head] * LOG2E - SHIFT);
    const float inv = 1.0f / lt;
    if constexpr (MOBA) {
        constexpr int OP = 272;
        ATT_LAS unsigned char* tb = lds + wave * (32 * OP);
#pragma unroll
        for (int db = 0; db < C::NDB; ++db)
#pragma unroll
            for (int g = 0; g < 4; ++g) {
                u32x2 w; w.x = pg8::cvt_pk_bf16(O[db][4 * g] * inv, O[db][4 * g + 1] * inv); w.y = pg8::cvt_pk_bf16(O[db][4 * g + 2] * inv, O[db][4 * g + 3] * inv);
                *(ATT_LAS u32x2*)(tb + q * OP + (32 * db + 8 * g + 4 * hi) * 2) = w;
            }
        bf16_t* Ow = (bf16_t*)(ws + WS_XN) + (size_t)(seqbase + qpos0 + 32 * wave) * 2048 + 1024 + head * 128 + 8 * (lane & 15);
#pragma unroll
        for (int j = 0; j < 8; ++j) {
            const int r = 4 * j + (lane >> 4);
            const u32x4 o = *(const ATT_LAS u32x4*)(tb + r * OP + 16 * (lane & 15));
            *(u32x4*)(Ow + (size_t)r * 2048) = o;
        }
        __syncthreads();
    } else {
#pragma unroll
        for (int db = 0; db < C::NDB; ++db)
#pragma unroll
            for (int g = 0; g < 4; ++g) {
                u32x2 w; w.x = pg8::cvt_pk_bf16(O[db][4 * g] * inv, O[db][4 * g + 1] * inv); w.y = pg8::cvt_pk_bf16(O[db][4 * g + 2] * inv, O[db][4 * g + 3] * inv);
                *(u32x2*)(Orow + 32 * db + 8 * g + 4 * hi) = w;
            }
    }
}

__device__ __forceinline__ void swa_phase(ATT_LAS unsigned char* lds, const Params& p, int bid, int nblk) {
    typedef Cfg<64> C;
    constexpr int TILE = C::STG, UBUF = 3 * TILE;
    const int tid = opaque_tid(), lane = tid & 63, wave = __builtin_amdgcn_readfirstlane(tid >> 6), q = lane & 31, hi = lane >> 5;
    unsigned char* ws = p.ws;
    const bf16_t *QA = (const bf16_t*)(ws + WS_QA), *KA = (const bf16_t*)(ws + WS_KA), *VA = (const bf16_t*)(ws + WS_VA);
    bf16_t* OAB = (bf16_t*)(ws + WS_XN);
    const int prow = tid >> 3, pch = tid & 7;
    const int lk = C::KP * prow + 16 * pch, lv = C::KBYTES + C::VP * prow + 16 * pch;
    const int ka = C::KP * q + 16 * hi;
    const int va = C::VP * (4 * hi + ((lane & 15) >> 2)) + 32 * ((lane >> 4) & 1) + 8 * (lane & 3);
    u32x4 kreg[3], vreg[3]; bf16x8 qn[C::NKS];
#define SWA_DEC(u, b_, g_, n_) const int _x##n_ = (u) & 7, _i##n_ = (u) >> 3, _bg##n_ = _x##n_ * 4 + (_i##n_ >> 5); const int b_ = _bg##n_ >> 2, g_ = _bg##n_ & 3, n_ = _i##n_ & 31
#define SWA_LOAD(u) do { SWA_DEC(u, b_, g_, n_); \
        const bf16_t* kt = KA + ((size_t)(b_ * SEQ + 64 * n_ + prow)) * 256 + g_ * 64 + pch * 8; const bf16_t* vt = VA + ((size_t)(b_ * SEQ + 64 * n_ + prow)) * 256 + g_ * 64 + pch * 8; \
        _Pragma("unroll") for (int _i = 0; _i < 3; ++_i) if (_i <= n_) { kreg[_i] = *(const u32x4*)(kt - (size_t)_i * 64 * 256); vreg[_i] = *(const u32x4*)(vt - (size_t)_i * 64 * 256); } \
        const bf16_t* qr = QA + ((size_t)(b_ * SEQ + 64 * n_ + 32 * (wave & 1) + q)) * 1024 + (4 * g_ + (wave >> 1)) * 64; \
        _Pragma("unroll") for (int ks = 0; ks < C::NKS; ++ks) qn[ks] = *(const bf16x8*)(qr + 16 * ks + 8 * hi); } while (0)
#define SWA_WRITE(u, buf) do { SWA_DEC(u, b_, g_, n_); (void)b_; (void)g_; \
        _Pragma("unroll") for (int _i = 0; _i < 3; ++_i) if (_i <= n_) { *(ATT_LAS u32x4*)(lds + (buf) * UBUF + _i * TILE + lk) = kreg[_i]; *(ATT_LAS u32x4*)(lds + (buf) * UBUF + _i * TILE + lv) = vreg[_i]; } } while (0)
    if (bid >= 1024) return;
    SWA_LOAD(bid); SWA_WRITE(bid, 0); __syncthreads();
    int j = 0;
    for (int u = bid; u < 1024; u += nblk, ++j) {
        bf16x8 qf[C::NKS];
#pragma unroll
        for (int ks = 0; ks < C::NKS; ++ks) qf[ks] = qn[ks];
        const int un = u + nblk; const bool more = un < 1024;
        if (more) SWA_LOAD(un);
        SWA_DEC(u, b, g, n);
        const int head = 4 * g + (wave >> 1), qpos0 = 64 * n, t = qpos0 + 32 * (wave & 1) + q;
        const float slope2 = exp2f(-0.5f * (float)(head + 1)) * LOG2E;
        f32x16 O[C::NDB];
#pragma unroll
        for (int db = 0; db < C::NDB; ++db)
#pragma unroll
            for (int r = 0; r < 16; ++r) O[db][r] = 0.f;
        float l = 0.f;
        const int sgn = wave & 1;
        const ATT_LAS unsigned char* ub = lds + (j & 1) * UBUF;
#define SWA_HALF(J, GUARD) do { if (!(GUARD) || (J) <= 2 * n + sgn) { \
            const int g_ = 1 - sgn + (J); \
            const ATT_LAS unsigned char* Kt = ub + (g_ >> 1) * TILE + (1 - (g_ & 1)) * 32 * C::KP; \
            const ATT_LAS unsigned char* Vt = ub + (g_ >> 1) * TILE + C::KBYTES + (1 - (g_ & 1)) * 32 * C::VP; \
            const float lb = slope2 * (float)(4 * hi - 32 * (J) - q) - SHIFT; \
            f32x16 s; \
            _Pragma("unroll") for (int r = 0; r < 16; ++r) { const int ko = 4 * hi + (r & 3) + 8 * (r >> 2); const float v = __builtin_fmaf(slope2, (float)((r & 3) + 8 * (r >> 2)), lb); \
                s[r] = ((J) == 0) ? (ko <= q ? v : NEG) : ((J) == 4) ? (ko >= q + 1 ? v : NEG) : v; } \
            _Pragma("unroll") for (int ks = 0; ks < C::NKS; ++ks) s = __builtin_amdgcn_mfma_f32_32x32x16_bf16(*(const ATT_LAS bf16x8*)(Kt + ka + 32 * ks), qf[ks], s, 0, 0, 0); \
            float ls0 = 0.f, ls1 = 0.f, ls2 = 0.f, ls3 = 0.f; \
            _Pragma("unroll") for (int r = 0; r < 16; r += 4) { s[r] = __builtin_amdgcn_exp2f(s[r]); s[r + 1] = __builtin_amdgcn_exp2f(s[r + 1]); s[r + 2] = __builtin_amdgcn_exp2f(s[r + 2]); s[r + 3] = __builtin_amdgcn_exp2f(s[r + 3]); \
                ls0 += s[r]; ls1 += s[r + 1]; ls2 += s[r + 2]; ls3 += s[r + 3]; } \
            l += (ls0 + ls1) + (ls2 + ls3); \
            bf16x8 pf[2]; \
            _Pragma("unroll") for (int ss = 0; ss < 2; ++ss) { u32x4 w; \
                w.x = pg8::cvt_pk_bf16(s[8 * ss + 0], s[8 * ss + 1]); w.y = pg8::cvt_pk_bf16(s[8 * ss + 2], s[8 * ss + 3]); w.z = pg8::cvt_pk_bf16(s[8 * ss + 4], s[8 * ss + 5]); w.w = pg8::cvt_pk_bf16(s[8 * ss + 6], s[8 * ss + 7]); \
                pf[ss] = __builtin_bit_cast(bf16x8, w); } \
            _Pragma("unroll") for (int db = 0; db < C::NDB; ++db) _Pragma("unroll") for (int ss = 0; ss < 2; ++ss) { \
                const s16x4 lo = vtr(Vt + va + 64 * db + C::VP * (16 * ss)), hh = vtr(Vt + va + 64 * db + C::VP * (16 * ss + 8)); \
                const bf16x8 vf = (bf16x8){lo[0], lo[1], lo[2], lo[3], hh[0], hh[1], hh[2], hh[3]}; \
                O[db] = __builtin_amdgcn_mfma_f32_32x32x16_bf16(vf, pf[ss], O[db], 0, 0, 0); } } } while (0)
        if (n >= 2) { SWA_HALF(0, false); SWA_HALF(1, false); SWA_HALF(2, false); SWA_HALF(3, false); SWA_HALF(4, false); }
        else        { SWA_HALF(0, true);  SWA_HALF(1, true);  SWA_HALF(2, true);  SWA_HALF(3, true);  SWA_HALF(4, true); }
#undef SWA_HALF
        const float lt = l + __shfl_xor(l, 32) + __builtin_amdgcn_exp2f(p.sinks[head] * LOG2E - SHIFT);
        const float inv = 1.0f / lt;
        bf16_t* Orow = OAB + (size_t)(b * SEQ + t) * 2048 + head * 64;
#pragma unroll
        for (int db = 0; db < C::NDB; ++db)
#pragma unroll
            for (int gq = 0; gq < 4; ++gq) {
                u32x2 w; w.x = pg8::cvt_pk_bf16(O[db][4 * gq] * inv, O[db][4 * gq + 1] * inv); w.y = pg8::cvt_pk_bf16(O[db][4 * gq + 2] * inv, O[db][4 * gq + 3] * inv);
                *(u32x2*)(Orow + 32 * db + 8 * gq + 4 * hi) = w;
            }
        if (more) SWA_WRITE(un, (j + 1) & 1);
        __syncthreads();
    }
#undef SWA_DEC
#undef SWA_LOAD
#undef SWA_WRITE
}

__device__ __forceinline__ void attn_phase(ATT_LAS unsigned char* lds, const Params& p, int bid, int nblk) {
    for (int uu = 0;; ++uu) {
        const int it = bid + (uu >> 1) * nblk; if (it >= 256) break;
        const int x = it & 7, idx = it >> 3, bh = x * 8 + (idx >> 2), s = idx & 3;
        attn_unit<128, true>(lds, p, bh >> 3, bh & 7, (uu & 1) ? 7 - s : s);
    }
    __syncthreads();
    swa_phase(lds, p, bid, nblk);
}
}

#define XB_TMO      128
#define XB_XCNT(j)  (256  + 64 * (j))
#define XB_XSUB(j)  (1280 + 64 * (j))
#define XB_XGEN(j)  (2304 + 64 * (j))
#define XB_TOP      3328
#define XB_TOPGEN   3392
#define XCD_BAR_WORDS 3456
#define XB_SPIN_CAP (1u << 18)
#define XLAS __attribute__((address_space(3)))
__device__ __forceinline__ unsigned xb_ld(unsigned* p)              { return __hip_atomic_load(p, __ATOMIC_RELAXED, __HIP_MEMORY_SCOPE_AGENT); }
__device__ __forceinline__ unsigned xb_add(unsigned* p, unsigned v) { return __hip_atomic_fetch_add(p, v, __ATOMIC_RELAXED, __HIP_MEMORY_SCOPE_AGENT); }
__device__ __forceinline__ unsigned xb_xcc_id() { return (unsigned)__builtin_amdgcn_s_getreg((3 << 11) | 20) & 0xFu; }
#define XB_SPIN(cond, bar) do { unsigned _sp = 0; while (cond) { __builtin_amdgcn_s_sleep(1); \
    if ((++_sp & 255u) == 0u) { if (xb_ld(&(bar)[XB_TMO])) break; if (_sp > XB_SPIN_CAP) { atomicAdd(&(bar)[XB_TMO], 1u); break; } } } } while (0)
struct XcdBarrier { unsigned* bar; unsigned x; volatile XLAS unsigned* st; };
__device__ __forceinline__ XcdBarrier xcd_barrier_post(unsigned* bar, volatile XLAS unsigned* st) {
    XcdBarrier b; b.bar = bar; b.x = xb_xcc_id(); b.st = st;
    if (threadIdx.x == 0) (void)xb_add(&bar[XB_XCNT(b.x)], 1u);
    return b;
}
__device__ __forceinline__ void xcd_barrier_complete(unsigned* bar, unsigned x, unsigned& nloc, unsigned& nx) {
    const unsigned G = gridDim.x * gridDim.y * gridDim.z;
    unsigned sum, cnt, mine, sp = 0u;
    for (;;) {
        sum = 0u; cnt = 0u; mine = 0u;
#pragma unroll
        for (unsigned j = 0; j < 16; ++j) { const unsigned c = xb_ld(&bar[XB_XCNT(j)]); sum += c; cnt += (c > 0u) ? 1u : 0u; mine = (j == x) ? c : mine; }
        if (sum == G) break;
        __builtin_amdgcn_s_sleep(1);
        if ((++sp & 255u) == 0u) { if (xb_ld(&bar[XB_TMO])) break; if (sp > XB_SPIN_CAP) { atomicAdd(&bar[XB_TMO], 1u); break; } }
    }
    nloc = mine > 0u ? mine : 1u; nx = cnt > 0u ? cnt : 1u;
}
__device__ __forceinline__ void xcd_barrier(const XcdBarrier& b) {
    asm volatile("s_waitcnt vmcnt(0)" ::: "memory");
    __syncthreads();
    if (threadIdx.x == 0) {
        unsigned* bar = b.bar;
        __builtin_amdgcn_s_waitcnt(0);
        unsigned nloc = b.st[0], nx = b.st[1];
        if (nloc == 0u) { xcd_barrier_complete(bar, b.x, nloc, nx); b.st[0] = nloc; b.st[1] = nx; }
        const unsigned old = xb_add(&bar[XB_XSUB(b.x)], 1u);
        const unsigned gen = old / nloc;
        if (old + 1u == (gen + 1u) * nloc) {
            __builtin_amdgcn_fence(__ATOMIC_RELEASE, "agent");
            asm volatile("s_waitcnt vmcnt(0)" ::: "memory");
            const unsigned og = xb_add(&bar[XB_TOP], 1u);
            const unsigned tg = og / nx;
            if (og + 1u == (tg + 1u) * nx) xb_add(&bar[XB_TOPGEN], 1u);
            else XB_SPIN(xb_ld(&bar[XB_TOPGEN]) == tg, bar);
            __builtin_amdgcn_fence(__ATOMIC_ACQUIRE, "agent");
            xb_add(&bar[XB_XGEN(b.x)], 1u);
            asm volatile("s_waitcnt vmcnt(0)" ::: "memory");
        } else {
            XB_SPIN(xb_ld(&bar[XB_XGEN(b.x)]) == gen, bar);
            __builtin_amdgcn_fence(__ATOMIC_ACQUIRE, "agent");
            asm volatile("s_waitcnt vmcnt(0)" ::: "memory");
        }
    }
    __syncthreads();
}

constexpr int LDS_BYTES = 147456, MISC_OFF = 131072 + 320, XCH_OFF = 131072 + 1024;
#define GRID_SYNC() xcd_barrier(xbar)
#define XB_CLUSTER(k) (4096 + 64 * (k))
__device__ __forceinline__ void cluster_barrier(unsigned* bar, int k, unsigned target, bool same_l2) {
    asm volatile("s_waitcnt vmcnt(0)" ::: "memory");
    __syncthreads();
    if (threadIdx.x == 0) {
        if (!same_l2) __builtin_amdgcn_fence(__ATOMIC_RELEASE, "agent");
        asm volatile("s_waitcnt vmcnt(0)" ::: "memory");
        (void)xb_add(&bar[XB_CLUSTER(k)], 1u);
        XB_SPIN(xb_ld(&bar[XB_CLUSTER(k)]) < target, bar);
        __builtin_amdgcn_fence(__ATOMIC_ACQUIRE, "agent");
        asm volatile("s_waitcnt vmcnt(0)" ::: "memory");
    }
    __syncthreads();
}
#ifndef P1_LAG_TICKS
#define P1_LAG_TICKS 1200
#endif
#ifndef PROBE_P0
#define PROBE_P0 1
#endif
#ifndef PROBE_P1
#define PROBE_P1 1
#endif
#ifndef PROBE_P15
#define PROBE_P15 1
#endif
#ifndef PROBE_ATT
#define PROBE_ATT 1
#endif
#ifndef PROBE_P3
#define PROBE_P3 1
#endif
#ifndef PROBE_P5
#define PROBE_P5 1
#endif
__global__ void __launch_bounds__(NTHREADS, 2) fwd_megakernel(Params p) {
    extern __shared__ __attribute__((aligned(16))) unsigned char lds[];
    const int bid = blockIdx.x, nblk = gridDim.x;
    unsigned char* ws = p.ws;
    PG8_LAS unsigned char* ring = (PG8_LAS unsigned char*)lds;
    volatile XLAS unsigned* misc = (volatile XLAS unsigned*)((XLAS unsigned char*)lds + MISC_OFF);
    if (threadIdx.x < 8) misc[threadIdx.x] = 0u;
    __syncthreads();
    const XcdBarrier xbar = xcd_barrier_post((unsigned*)(ws + WS_CTL), misc);
    const bool clustered = (nblk == 256); const int cluster = 8 * (bid & 7) + ((bid >> 3) & 7); const unsigned csize = 4u;
    if (threadIdx.x == 0) __hip_atomic_store((unsigned*)(ws + WS_CTL) + 8192 + bid, xbar.x, __ATOMIC_RELAXED, __HIP_MEMORY_SCOPE_AGENT);
    bool same_l2 = false;
#define SEAM_SYNC(n) do { if (clustered) cluster_barrier((unsigned*)(ws + WS_CTL), cluster, (unsigned)(n) * csize, same_l2); else GRID_SYNC(); } while (0)
    const int n9 = (M / 256) * (NIN / 256) - 8 * nblk; const bool defer_late = (nblk == 256);
    { p0_prologue(p, defer_late, bid, nblk, (P0_LAS unsigned char*)lds); GRID_SYNC(); }
    if (clustered) {
        const unsigned* ids = (const unsigned*)(ws + WS_CTL) + 8192; const int b0 = (bid & 7) + 8 * ((bid >> 3) & 7);
        const unsigned i0 = xb_ld((unsigned*)ids + b0), i1 = xb_ld((unsigned*)ids + b0 + 64), i2 = xb_ld((unsigned*)ids + b0 + 128), i3 = xb_ld((unsigned*)ids + b0 + 192);
        same_l2 = (i0 == i1) && (i1 == i2) && (i2 == i3);
    }
#if PROBE_P0 > 1
    { p0_prologue(p, defer_late, bid, nblk, (P0_LAS unsigned char*)lds); GRID_SYNC(); }
#endif

    {
        if (defer_late && bid >= n9) { const int lw = (bid - n9) * NWAVES + (threadIdx.x >> 6), LNW = (nblk - n9) * NWAVES;
            p0_weights<1>(p, lw, LNW, (P0_LAS unsigned char*)lds); p0_weights<2>(p, lw, LNW, (P0_LAS unsigned char*)lds); __syncthreads(); }
        pg8::Gemm g{(const bf16_t*)(ws + WS_XN), (const bf16_t*)(ws + WS_WIN), 2048, 2048, 32, 0}; pg8::TileOrder<1> S; S.init(M, NIN, nblk, bid);
        pg8::EpiZ E{ws, p.b_gate, p.qna, p.kna, p.knb, (PG8_LAS float*)((PG8_LAS unsigned char*)lds + XCH_OFF)}; pg8::gemm_phase(ring, g, S, E); GRID_SYNC(); }
#if PROBE_P1 > 1
    {
        pg8::Gemm g{(const bf16_t*)(ws + WS_XN), (const bf16_t*)(ws + WS_WIN), 2048, 2048, 32, 0}; pg8::TileOrder<1> S; S.init(M, NIN, nblk, bid);
        pg8::EpiZ E{ws, p.b_gate, p.qna, p.kna, p.knb, (PG8_LAS float*)((PG8_LAS unsigned char*)lds + XCH_OFF)}; pg8::gemm_phase(ring, g, S, E); GRID_SYNC(); }
#endif

    { att::attn_phase((ATT_LAS unsigned char*)lds, p, bid, nblk); GRID_SYNC(); }
#if PROBE_ATT > 1
    { att::attn_phase((ATT_LAS unsigned char*)lds, p, bid, nblk); GRID_SYNC(); }
#endif

    {
        pg8::Gemm g{(const bf16_t*)(ws + WS_XN), (const bf16_t*)(ws + WS_WAB), 2048, 2048, 16, 1024}; pg8::TileOrder<2> S; S.init(M, DM, nblk, bid);
        pg8::EpiMixed E{(const bf16_t*)(ws + WS_GATES), (bf16_t*)(ws + WS_MIXED)}; pg8::gemm_phase(ring, g, S, E); SEAM_SYNC(1); }

    { pg8::Gemm g{(const bf16_t*)(ws + WS_MIXED), (const bf16_t*)(ws + WS_WO), 4096, 2048, 32, 0}; pg8::TileOrder<1> S; S.init(M, DM, nblk, bid);
      pg8::EpiWo E{p.x, p.out, (bf16_t*)(ws + WS_XN), (float*)(ws + WS_SUMSQ)}; pg8::gemm_phase(ring, g, S, E); }
    SEAM_SYNC(2);
    {
        pg8::Gemm g{(const bf16_t*)(ws + WS_XN), (const bf16_t*)(ws + WS_WGU), 2048, 2048, 32, 0}; pg8::TileOrder<1> S; S.init(M, 2 * DFF, nblk, bid);
        pg8::EpiSwiglu E{(const float*)(ws + WS_SUMSQ), (bf16_t*)(ws + WS_ACT)}; pg8::gemm_phase(ring, g, S, E); SEAM_SYNC(3); }

    { pg8::Gemm g{(const bf16_t*)(ws + WS_ACT), (const bf16_t*)(ws + WS_WD), DFF, DFF, DFF / 64, 0, (unsigned)ACT_GAP, ACT_GAP_FROM}; pg8::TileOrder<1> S; S.init(M, DM, nblk, bid);
      pg8::EpiDown E{p.out, (const bf16_t*)(ws + WS_XN)}; pg8::gemm_phase(ring, g, S, E); }
}

extern "C" void kernel_launch(void* const* d_in, const int* in_sizes, int n_in, void* d_out, int out_size, void* d_ws, size_t ws_size, hipStream_t stream) {
    if (n_in != 16 || ws_size < WS_END) { fprintf(stderr, "kernel_launch: unexpected n_in %d / ws_size %zu\n", n_in, ws_size); return; }
    static int grid_blocks = 0;
    if (!grid_blocks) {
        int dev = 0, cus = 0, per_cu = 0;
        (void)hipGetDevice(&dev);
        (void)hipDeviceGetAttribute(&cus, hipDeviceAttributeMultiprocessorCount, dev);
        (void)hipFuncSetAttribute((const void*)fwd_megakernel, hipFuncAttributeMaxDynamicSharedMemorySize, LDS_BYTES);
        (void)hipOccupancyMaxActiveBlocksPerMultiprocessor(&per_cu, (const void*)fwd_megakernel, NTHREADS, LDS_BYTES);
        if (per_cu < 1) per_cu = 1;
        grid_blocks = cus * per_cu;
        fprintf(stderr, "kernel_launch: cus %d per_cu %d grid %d\n", cus, per_cu, grid_blocks);
    }
    Params p{};
    p.x = (const float*)d_in[0]; p.norm1_g = (const float*)d_in[1]; p.w_in = (const float*)d_in[2]; p.b_gate = (const float*)d_in[3];
    p.qna = (const float*)d_in[4]; p.kna = (const float*)d_in[5]; p.sinks = (const float*)d_in[6]; p.qnb = (const float*)d_in[7]; p.knb = (const float*)d_in[8];
    p.wba = (const float*)d_in[9]; p.wbb = (const float*)d_in[10]; p.wo = (const float*)d_in[11]; p.norm2_g = (const float*)d_in[12];
    p.wg = (const float*)d_in[13]; p.wu = (const float*)d_in[14]; p.wd = (const float*)d_in[15];
    p.out = (float*)d_out; p.ws = (unsigned char*)d_ws;
    (void)hipMemsetAsync((char*)d_ws + WS_CTL, 0, 32768, stream);
    void* args[] = {&p};
    hipError_t e = hipLaunchCooperativeKernel((const void*)fwd_megakernel, dim3(grid_blocks), dim3(NTHREADS), args, LDS_BYTES, stream);
    if (e != hipSuccess) fprintf(stderr, "cooperative launch failed: %s (grid %d)\n", hipGetErrorString(e), grid_blocks);
}
```

```cpp
#include <hip/hip_runtime.h>
#include <stdint.h>
#include <type_traits>
#include <cstdio>

typedef unsigned short bf16_t;
typedef short bf16x8 __attribute__((ext_vector_type(8)));
typedef float f32x4 __attribute__((ext_vector_type(4)));
typedef unsigned u32x4 __attribute__((ext_vector_type(4)));
typedef unsigned u32x2 __attribute__((ext_vector_type(2)));

constexpr int BATCH = 8, SEQ = 2048, DM = 2048, M = BATCH * SEQ;
constexpr int NIN = 8704, DFF = 5632;
constexpr int C_QA = 0, C_KA = 1024, C_VA = 1280, C_QB = 1536, C_KB = 2560, C_VB = 3584, C_G = 4608;
constexpr float RMS_EPS = 1e-6f;
constexpr float LOG2E = 1.4426950408889634f;
constexpr float SC_QA = 0.125f * LOG2E, SC_QB = 0.08838834764831845f * LOG2E;
constexpr int NWAVES = 8, NTHREADS = 512;

constexpr size_t MiB = 1u << 20;
constexpr size_t WS_CTL = 0;
constexpr size_t WS_SUMSQ = 1 * MiB;
constexpr size_t WS_KMEAN = 1 * MiB + 128 * 1024;
constexpr size_t WS_WIN = 2 * MiB;
constexpr size_t WS_WAB = 36 * MiB;
constexpr size_t WS_WO = 44 * MiB;
constexpr size_t WS_WGU = 52 * MiB;
constexpr size_t WS_WD = 96 * MiB;
constexpr size_t WS_XN = 118 * MiB;
constexpr size_t WS_QA = 182 * MiB;
constexpr size_t WS_KA = 214 * MiB;
constexpr size_t WS_VA = 222 * MiB;
constexpr size_t WS_QB = 230 * MiB;
constexpr size_t WS_KB = 262 * MiB;
constexpr size_t WS_VB = 294 * MiB;
constexpr size_t WS_GATES = 326 * MiB;
constexpr size_t WS_MIXED = WS_GATES;
constexpr size_t WS_ACT = 182 * MiB;
constexpr int    ACT_GAP_FROM = 52;
constexpr size_t ACT_GAP = (454 - 182) * MiB - (size_t)ACT_GAP_FROM * 256 * 5632 * 2;
constexpr size_t WS_END = 487 * MiB;

struct Params {
    const float *x, *norm1_g, *w_in, *b_gate, *qna, *kna, *sinks, *qnb, *knb, *wba, *wbb, *wo, *norm2_g, *wg, *wu, *wd;
    float* out; unsigned char* ws;
};

__device__ __forceinline__ int opaque_tid() { int t = threadIdx.x; asm volatile("" : "+v"(t)); return t; }
__device__ __forceinline__ unsigned f2bf(float f) { unsigned u = __builtin_bit_cast(unsigned, f); return (u + 0x7fffu + ((u >> 16) & 1u)) >> 16; }
__device__ __forceinline__ unsigned pk2(float lo, float hi) { return f2bf(lo) | (f2bf(hi) << 16); }
__device__ __forceinline__ float bf2f(unsigned short b) { return __builtin_bit_cast(float, (unsigned)b << 16); }
__device__ __forceinline__ float bflo(unsigned w) { return __builtin_bit_cast(float, w << 16); }
__device__ __forceinline__ float bfhi(unsigned w) { return __builtin_bit_cast(float, w & 0xffff0000u); }
__device__ __forceinline__ float wave_sum(float v) {
#pragma unroll
    for (int o = 1; o < 64; o <<= 1) v += __shfl_xor(v, o);
    return v;
}
__device__ __forceinline__ float wave_max(float v) {
#pragma unroll
    for (int o = 1; o < 64; o <<= 1) v = fmaxf(v, __shfl_xor(v, o));
    return v;
}

typedef float f32x2_t __attribute__((ext_vector_type(2))); typedef __bf16 bf16x2_t __attribute__((ext_vector_type(2)));
__device__ __forceinline__ unsigned cvt2(float lo, float hi) { f32x2_t v = {lo, hi}; bf16x2_t b = __builtin_convertvector(v, bf16x2_t); return __builtin_bit_cast(unsigned, b); }
#define P0_LAS __attribute__((address_space(3)))
__device__ __forceinline__ int p0_drow(int n, int mapk) {
    if (mapk == 0) return n;
    if (mapk == 3 || (mapk == 4 && n < C_G)) return (n & ~255) + 128 * ((n >> 5) & 1) + 32 * ((n >> 6) & 3) + (n & 31);
    if (mapk == 4) { const int g = (n >= C_G + 2048) ? 1 : 0, c = n - C_G - 2048 * g; return C_G + 256 * (c >> 7) + 128 * g + (c & 127); }
    return 256 * (n >> 7) + (n & 127) + (mapk == 2 ? 128 : 0);
}
struct WItem { const float* src; const float* ks; bf16_t* d; int ldw, ldd, n0, mapk; };
__device__ __forceinline__ WItem p0_mk(const float* W, int ldw, int n0, int k0, const float* kscale, bf16_t* dst, int ldd, int dstk0, int mapk, int lane) {
    const int l = lane & 31, h = lane >> 5;
    WItem it; it.src = W + (size_t)(k0 + 16 * h) * ldw + n0 + 4 * l; it.ks = kscale ? kscale + k0 + 16 * h : nullptr;
    it.d = dst + dstk0 + k0 + 8 * (lane & 7); it.ldw = ldw; it.ldd = ldd; it.n0 = n0; it.mapk = mapk; return it;
}
__device__ __forceinline__ void p0_ld(const WItem& it, int b, f32x4 (&v)[16]) {
#pragma unroll
    for (int i = 0; i < 16; ++i) v[i] = __builtin_nontemporal_load((const f32x4*)(it.src + (size_t)(32 * b + i) * it.ldw));
}
__device__ __forceinline__ void p0_tolds(const WItem& it, int b, f32x4 (&v)[16], P0_LAS unsigned char* buf, int lane) {
    if (it.ks) {
#pragma unroll
        for (int i = 0; i < 16; ++i) v[i] = v[i] * it.ks[32 * b + i];
    }
    const int l = lane & 31, h = lane >> 5;
#pragma unroll
    for (int e = 0; e < 4; ++e)
#pragma unroll
        for (int q = 0; q < 2; ++q) {
            u32x4 o; o.x = cvt2(v[8 * q + 0][e], v[8 * q + 1][e]); o.y = cvt2(v[8 * q + 2][e], v[8 * q + 3][e]); o.z = cvt2(v[8 * q + 4][e], v[8 * q + 5][e]); o.w = cvt2(v[8 * q + 6][e], v[8 * q + 7][e]);
            const int c = 4 * b + 2 * h + q;
            *(P0_LAS u32x4*)(buf + (4 * l + e) * 128 + ((c ^ (l & 7)) << 4)) = o;
        }
}
__device__ __forceinline__ void p0_flush(const WItem& it, P0_LAS unsigned char* buf, int lane) {
#pragma unroll
    for (int j = 0; j < 16; ++j) {
        const int r = 8 * j + (lane >> 3), c = lane & 7;
        const u32x4 o = *(const P0_LAS u32x4*)(buf + r * 128 + ((c ^ ((r >> 2) & 7)) << 4));
        *(u32x4*)(it.d + (size_t)p0_drow(it.n0 + r, it.mapk) * it.ldd) = o;
    }
}
template <int SET> __device__ __forceinline__ int p0_count() { return SET == 0 ? 68 * 32 + 2 * 44 * 32 : SET == 1 ? 2 * 16 * 16 + 16 * 32 : 16 * 88; }
template <int SET> __device__ __forceinline__ WItem p0_decode(const Params& p, int r, int lane) {
    unsigned char* ws = p.ws;
    if (SET == 0) {
        constexpr int I_G = 44 * 32;
        if (r < I_G) return p0_mk(p.wg, DFF, 128 * (r >> 5), 64 * (r & 31), p.norm2_g, (bf16_t*)(ws + WS_WGU), 2048, 0, 1, lane);
        r -= I_G;
        if (r < I_G) return p0_mk(p.wu, DFF, 128 * (r >> 5), 64 * (r & 31), p.norm2_g, (bf16_t*)(ws + WS_WGU), 2048, 0, 2, lane);
        r -= I_G;
        return p0_mk(p.w_in, NIN, 128 * (r >> 5), 64 * (r & 31), nullptr, (bf16_t*)(ws + WS_WIN), 2048, 0, 4, lane);
    } else if (SET == 1) {
        constexpr int I_BA = 16 * 16;
        if (r < I_BA) return p0_mk(p.wba, 2048, 128 * (r >> 4), 64 * (r & 15), nullptr, (bf16_t*)(ws + WS_WAB), 2048, 0, 3, lane);
        r -= I_BA;
        if (r < I_BA) return p0_mk(p.wbb, 2048, 128 * (r >> 4), 64 * (r & 15), nullptr, (bf16_t*)(ws + WS_WAB), 2048, 1024, 3, lane);
        r -= I_BA;
        return p0_mk(p.wo, 2048, 128 * (r >> 5), 64 * (r & 31), nullptr, (bf16_t*)(ws + WS_WO), 2048, 0, 3, lane);
    } else {
        return p0_mk(p.wd, 2048, 128 * (r / 88), 64 * (r % 88), nullptr, (bf16_t*)(ws + WS_WD), DFF, 0, 3, lane);
    }
}
template <int SET>
__device__ __forceinline__ void p0_weights(const Params& p, int gw, int NGW, P0_LAS unsigned char* lds) {
    const int tid = opaque_tid(), lane = tid & 63; const int cnt = p0_count<SET>();
    if (gw >= cnt) return;
    P0_LAS unsigned char* buf = lds + (tid >> 6) * 16384;
    f32x4 va[16], vb[16];
    WItem cur = p0_decode<SET>(p, gw, lane);
    p0_ld(cur, 0, va);
    for (int it = gw; it < cnt; it += NGW) {
        p0_ld(cur, 1, vb);
        p0_tolds(cur, 0, va, buf, lane);
        const bool more = it + NGW < cnt;
        WItem nxt = cur;
        if (more) { nxt = p0_decode<SET>(p, it + NGW, lane); p0_ld(nxt, 0, va); }
        p0_tolds(cur, 1, vb, buf, lane);
        p0_flush(cur, buf, lane);
        cur = nxt;
    }
}

__device__ __forceinline__ void p0_prologue(const Params& p, bool defer_late, int bid, int nblk, P0_LAS unsigned char* lds) {
    const int tid = opaque_tid(), lane = tid & 63, wave = tid >> 6;
    const int gw = bid * NWAVES + wave, NGW = nblk * NWAVES;
    unsigned char* ws = p.ws;
    float* z = (float*)(ws + WS_SUMSQ);
    for (int i = bid * NTHREADS + tid; i < 16384; i += nblk * NTHREADS) z[i] = 0.f;
    int* z2 = (int*)(ws + WS_KMEAN);
    for (int i = bid * NTHREADS + tid; i < 65536; i += nblk * NTHREADS) z2[i] = 0;
    if (!defer_late) { p0_weights<2>(p, gw, NGW, lds); p0_weights<1>(p, gw, NGW, lds); }
    p0_weights<0>(p, gw, NGW, lds);
    bf16_t* XN = (bf16_t*)(ws + WS_XN);
    if (gw < M) {
        f32x4 v[8], w[8];
        { const f32x4* xr = (const f32x4*)(p.x + (size_t)gw * DM) + lane;
#pragma unroll
          for (int j = 0; j < 8; ++j) v[j] = __builtin_nontemporal_load(xr + 64 * j); }
        for (int m = gw; m < M; m += NGW) {
            const bool more = m + NGW < M;
            if (more) { const f32x4* xr = (const f32x4*)(p.x + (size_t)(m + NGW) * DM) + lane;
#pragma unroll
                for (int j = 0; j < 8; ++j) w[j] = __builtin_nontemporal_load(xr + 64 * j); }
            float s = 0.f;
#pragma unroll
            for (int j = 0; j < 8; ++j) s += (v[j].x * v[j].x + v[j].y * v[j].y) + (v[j].z * v[j].z + v[j].w * v[j].w);
            const float rstd = rsqrtf(wave_sum(s) * (1.f / DM) + RMS_EPS);
            u32x2* o8 = (u32x2*)(XN + (size_t)m * DM) + lane;
#pragma unroll
            for (int j = 0; j < 8; ++j) { const f32x4 g = ((const f32x4*)p.norm1_g)[64 * j + lane];
                u32x2 o; o.x = cvt2(v[j].x * rstd * g.x, v[j].y * rstd * g.y); o.y = cvt2(v[j].z * rstd * g.z, v[j].w * rstd * g.w);
                o8[64 * j] = o; }
#pragma unroll
            for (int j = 0; j < 8; ++j) v[j] = w[j];
        }
    }
}

__device__ __forceinline__ void unpack8(const u32x4 w, float (&f)[8]) {
    f[0] = bflo(w.x); f[1] = bfhi(w.x); f[2] = bflo(w.y); f[3] = bfhi(w.y); f[4] = bflo(w.z); f[5] = bfhi(w.z); f[6] = bflo(w.w); f[7] = bfhi(w.w);
}
namespace pg8 {
#define PG8_LAS __attribute__((address_space(3)))
constexpr int BM = 256, BK = 64, HALF = 128, HTB = HALF * BK * 2, STAGE_BYTES = 8 * HTB, NXCD = 8, WGM = 8;
__host__ __device__ __forceinline__ int lds_byte(int r, int c) { const int st = (r >> 4) * 2 + (c >> 5), rr = r & 15, cc = c & 31, ob = rr * 64 + cc * 2; return st * 1024 + (ob ^ (((ob >> 9) & 1) << 5)); }
__host__ __device__ __forceinline__ void stage_rc(int b, int& R, int& C) { const int st = b / 1024, sb = b % 1024, swz = sb ^ (((sb >> 9) & 1) << 5); R = (st >> 1) * 16 + swz / 64; C = (st & 1) * 32 + (swz % 64) / 2; }
__host__ __device__ __forceinline__ int perm32(int rho) { const int n = rho >> 4, i = rho & 15; return 8 * (i >> 2) + 4 * n + (i & 3); }

struct Unit { int pm, pn, pass; };
struct Gemm { const bf16_t* A; const bf16_t* Bt; int lda, ldb, nt, kpass; unsigned gapA; int gapFrom; };

template <int NPASS> struct TileOrder {
    int nM, nN, nwg, G, c;
    __device__ void init(int M_, int N_, int G_, int c_) { nM = M_ / BM; nN = N_ / BM; nwg = nM * nN; G = G_; c = c_; }
    __device__ bool next(int i, Unit& u) const {
        const int ti = i / NPASS; u.pass = i % NPASS;
        const long L = (long)ti * G + c; if (L >= nwg) return false;
        int wgid = (int)L; { const int q = nwg / NXCD, r = nwg % NXCD, xcd = wgid % NXCD, off = wgid / NXCD; wgid = (xcd < r ? xcd * (q + 1) : r * (q + 1) + (xcd - r) * q) + off; }
        const int nig = WGM * nN, gid = wgid / nig, fm = gid * WGM, gsz = (nM - fm) < WGM ? (nM - fm) : WGM;
        u.pm = fm + ((wgid % nig) % gsz); u.pn = (wgid % nig) / gsz;
        u.pn = (u.pn + 4 * (int)(L % NXCD)) % nN;
        return true;
    }
};

__device__ __forceinline__ unsigned cvt_pk_bf16(float lo, float hi) { f32x2_t v = {lo, hi}; bf16x2_t b = __builtin_convertvector(v, bf16x2_t); return __builtin_bit_cast(unsigned, b); }
__device__ __forceinline__ u32x4 pack8(const f32x4 v0, const f32x4 v1) { u32x4 w; w.x = cvt_pk_bf16(v0[0], v0[1]); w.y = cvt_pk_bf16(v0[2], v0[3]); w.z = cvt_pk_bf16(v1[0], v1[1]); w.w = cvt_pk_bf16(v1[2], v1[3]); return w; }
__device__ __forceinline__ float fast_sigmoid(float x) { return __builtin_amdgcn_rcpf(1.0f + __builtin_amdgcn_exp2f(-1.4426950408889634f * x)); }

struct EpiZ {
    static constexpr bool PERM = true;
    struct Pre {}; __device__ __forceinline__ Pre prefetch(const Unit&, int, int, int, int) const { return Pre{}; }
    unsigned char* ws; const float* b_gate; const float* qna; const float* kna; const float* knb; PG8_LAS float* xch;
    __device__ __forceinline__ bool operator()(f32x4 (&acc)[2][2][4][2], const Unit& u, int wr, int wc, int fr, int fq, const Pre&) const {
        const int colt = u.pn * BM, row0 = u.pm * BM + wr * 64 + fr;
        if (colt >= C_KB && colt < C_VB) {
            float ssr[2][4];
#pragma unroll
            for (int ai = 0; ai < 2; ++ai)
#pragma unroll
                for (int m = 0; m < 4; ++m) { float ss = 0.f;
#pragma unroll
                    for (int bj = 0; bj < 2; ++bj)
#pragma unroll
                        for (int n = 0; n < 2; ++n) { const f32x4 v = acc[ai][bj][m][n]; ss += (v[0] * v[0] + v[1] * v[1]) + (v[2] * v[2] + v[3] * v[3]); }
                    ss += __shfl_xor(ss, 16); ss += __shfl_xor(ss, 32); ssr[ai][m] = ss;
                    if (fq == 0) xch[(wr * 4 + wc) * 128 + (ai * 4 + m) * 16 + fr] = ss; }
            asm volatile("s_waitcnt lgkmcnt(0)" ::: "memory"); __builtin_amdgcn_s_barrier(); asm volatile("" ::: "memory");
            const int d0 = 64 * (wc & 1) + 8 * fq;
            f32x4 gv[2][2];
#pragma unroll
            for (int bj = 0; bj < 2; ++bj)
#pragma unroll
                for (int n = 0; n < 2; ++n) gv[bj][n] = *(const f32x4*)(knb + d0 + 32 * bj + 4 * n);
            f32x4 cs[2][2];
#pragma unroll
            for (int bj = 0; bj < 2; ++bj)
#pragma unroll
                for (int n = 0; n < 2; ++n) cs[bj][n] = (f32x4){0.f, 0.f, 0.f, 0.f};
            bf16_t* base = (bf16_t*)(ws + WS_KB); const int col0 = (colt - C_KB) + wc * 64 + 8 * fq;
#pragma unroll
            for (int ai = 0; ai < 2; ++ai)
#pragma unroll
                for (int m = 0; m < 4; ++m) {
                    const float tot = ssr[ai][m] + xch[(wr * 4 + (wc ^ 1)) * 128 + (ai * 4 + m) * 16 + fr];
                    const float rs = rsqrtf(tot * (1.f / 128.f) + RMS_EPS);
                    bf16_t* rowp = base + (size_t)(row0 + ai * HALF + m * 16) * 1024 + col0;
#pragma unroll
                    for (int bj = 0; bj < 2; ++bj) { const f32x4 y0 = acc[ai][bj][m][0] * rs * gv[bj][0], y1 = acc[ai][bj][m][1] * rs * gv[bj][1];
                        cs[bj][0] += y0; cs[bj][1] += y1;
                        *(u32x4*)(rowp + bj * 32) = pack8(y0, y1); } }
            int* km = (int*)(ws + WS_KMEAN) + (size_t)u.pm * 1024 + col0;
#pragma unroll
            for (int bj = 0; bj < 2; ++bj)
#pragma unroll
                for (int n = 0; n < 2; ++n)
#pragma unroll
                    for (int e = 0; e < 4; ++e) { float v = cs[bj][n][e];
                        v += __shfl_xor(v, 1); v += __shfl_xor(v, 2); v += __shfl_xor(v, 4); v += __shfl_xor(v, 8);
                        if (fr == 0) atomicAdd(km + 32 * bj + 4 * n + e, __float2int_rn(v * 262144.f)); }
            return false;
        }
        bf16_t* base; int ldc, cl;
        if (colt < C_KA) { base = (bf16_t*)(ws + WS_QA); ldc = 1024; cl = colt - C_QA; }
        else if (colt < C_VA) { base = (bf16_t*)(ws + WS_KA); ldc = 256; cl = colt - C_KA; }
        else if (colt < C_QB) { base = (bf16_t*)(ws + WS_VA); ldc = 256; cl = colt - C_VA; }
        else if (colt < C_KB) { base = (bf16_t*)(ws + WS_QB); ldc = 1024; cl = colt - C_QB; }
        else if (colt < C_VB) { base = (bf16_t*)(ws + WS_KB); ldc = 1024; cl = colt - C_KB; }
        else if (colt < C_G) { base = (bf16_t*)(ws + WS_VB); ldc = 1024; cl = colt - C_VB; }
        else { base = (bf16_t*)(ws + WS_GATES); ldc = 4096; cl = colt - C_G; }
        const int col0 = cl + wc * 64 + 8 * fq;
        if (colt < C_VA) {
            const float* g = (colt < C_KA) ? qna : kna; const float sc = (colt < C_KA) ? SC_QA : 1.0f;
            f32x4 gv[2][2];
#pragma unroll
            for (int bj = 0; bj < 2; ++bj)
#pragma unroll
                for (int n = 0; n < 2; ++n) gv[bj][n] = *(const f32x4*)(g + 32 * bj + 8 * fq + 4 * n) * sc;
#pragma unroll
            for (int ai = 0; ai < 2; ++ai)
#pragma unroll
                for (int m = 0; m < 4; ++m) { bf16_t* rowp = base + (size_t)(row0 + ai * HALF + m * 16) * ldc + col0;
                    float ss = 0.f;
#pragma unroll
                    for (int bj = 0; bj < 2; ++bj)
#pragma unroll
                        for (int n = 0; n < 2; ++n) { const f32x4 v = acc[ai][bj][m][n]; ss += (v[0] * v[0] + v[1] * v[1]) + (v[2] * v[2] + v[3] * v[3]); }
                    ss += __shfl_xor(ss, 16); ss += __shfl_xor(ss, 32);
                    const float rs = rsqrtf(ss * (1.f / 64.f) + RMS_EPS);
#pragma unroll
                    for (int bj = 0; bj < 2; ++bj) *(u32x4*)(rowp + bj * 32) = pack8(acc[ai][bj][m][0] * rs * gv[bj][0], acc[ai][bj][m][1] * rs * gv[bj][1]); }
        } else if (colt < C_G) {
#pragma unroll
            for (int ai = 0; ai < 2; ++ai)
#pragma unroll
                for (int m = 0; m < 4; ++m) { bf16_t* rowp = base + (size_t)(row0 + ai * HALF + m * 16) * ldc + col0;
#pragma unroll
                    for (int bj = 0; bj < 2; ++bj) *(u32x4*)(rowp + bj * 32) = pack8(acc[ai][bj][m][0], acc[ai][bj][m][1]); }
        } else {
            const int mc0 = ((colt - C_G) >> 1) + wc * 32 + 8 * fq;
            f32x4 ba[2], bb[2];
#pragma unroll
            for (int n = 0; n < 2; ++n) { ba[n] = *(const f32x4*)(b_gate + mc0 + 4 * n); bb[n] = *(const f32x4*)(b_gate + 2048 + mc0 + 4 * n); }
#pragma unroll
            for (int ai = 0; ai < 2; ++ai)
#pragma unroll
                for (int m = 0; m < 4; ++m) { bf16_t* rowp = (bf16_t*)(ws + WS_GATES) + (size_t)(row0 + ai * HALF + m * 16) * 4096 + mc0;
                    f32x4 r0, r1, g0, g1;
#pragma unroll
                    for (int e = 0; e < 4; ++e) {
                        const float ea0 = __builtin_amdgcn_exp2f(-1.4426950408889634f * (acc[ai][0][m][0][e] + ba[0][e])), ea1 = __builtin_amdgcn_exp2f(-1.4426950408889634f * (acc[ai][0][m][1][e] + ba[1][e]));
                        const float eb0 = __builtin_amdgcn_exp2f(-1.4426950408889634f * (acc[ai][1][m][0][e] + bb[0][e])), eb1 = __builtin_amdgcn_exp2f(-1.4426950408889634f * (acc[ai][1][m][1][e] + bb[1][e]));
                        g0[e] = __builtin_amdgcn_rcpf(1.0f + eb0); g1[e] = __builtin_amdgcn_rcpf(1.0f + eb1);
                        r0[e] = (1.0f + eb0) * __builtin_amdgcn_rcpf(1.0f + ea0); r1[e] = (1.0f + eb1) * __builtin_amdgcn_rcpf(1.0f + ea1);
                    }
                    *(u32x4*)(rowp) = pack8(r0, r1); *(u32x4*)(rowp + 2048) = pack8(g0, g1); }
        }
        return false;
    }
};
struct EpiMixed {
    static constexpr bool PERM = true;
    struct Pre {}; __device__ __forceinline__ Pre prefetch(const Unit&, int, int, int, int) const { return Pre{}; }
    const bf16_t* G; bf16_t* MX;
    __device__ __forceinline__ bool operator()(f32x4 (&acc)[2][2][4][2], const Unit& u, int wr, int wc, int fr, int fq, const Pre&) const {
        const int row0 = u.pm * BM + wr * 64 + fr, col0 = u.pn * BM + wc * 64 + 8 * fq;
#pragma unroll
        for (int ai = 0; ai < 2; ++ai)
#pragma unroll
            for (int m = 0; m < 4; ++m) { const size_t row = (size_t)(row0 + ai * HALF + m * 16);
#pragma unroll
                for (int bj = 0; bj < 2; ++bj) { const int col = col0 + bj * 32;
                    const u32x4 gw = *(const u32x4*)(G + row * 4096 + (u.pass == 0 ? 0 : 2048) + col);
                    float gg[8]; unpack8(gw, gg);
                    if (u.pass == 0) {
#pragma unroll
                        for (int e = 0; e < 4; ++e) { acc[ai][bj][m][0][e] *= gg[e]; acc[ai][bj][m][1][e] *= gg[4 + e]; }
                    } else {
                        f32x4 v0, v1;
#pragma unroll
                        for (int e = 0; e < 4; ++e) { v0[e] = acc[ai][bj][m][0][e] * gg[e]; v1[e] = acc[ai][bj][m][1][e] * gg[4 + e]; }
                        *(u32x4*)(MX + row * 4096 + col) = pack8(v0, v1);
                    } } }
        return u.pass == 0;
    }
};
struct EpiWo {
    static constexpr bool PERM = true;
    struct Pre {}; __device__ __forceinline__ Pre prefetch(const Unit&, int, int, int, int) const { return Pre{}; }
    const float* x; float* out; bf16_t* H1B; float* sumsq;
    __device__ __forceinline__ bool operator()(f32x4 (&acc)[2][2][4][2], const Unit& u, int wr, int wc, int fr, int fq, const Pre&) const {
        const int row0 = u.pm * BM + wr * 64 + fr, col0 = u.pn * BM + wc * 64 + 8 * fq;
#pragma unroll
        for (int ai = 0; ai < 2; ++ai)
#pragma unroll
            for (int m = 0; m < 4; ++m) { const int row = row0 + ai * HALF + m * 16; const size_t off = (size_t)row * DM + col0; float ss = 0.f;
#pragma unroll
                for (int bj = 0; bj < 2; ++bj) { const size_t o = off + bj * 32;
                    const f32x4 h0 = *(const f32x4*)(x + o) + acc[ai][bj][m][0], h1 = *(const f32x4*)(x + o + 4) + acc[ai][bj][m][1];
                    *(u32x4*)(H1B + o) = pack8(h0, h1);
                    ss += ((h0[0] * h0[0] + h0[1] * h0[1]) + (h0[2] * h0[2] + h0[3] * h0[3])) + ((h1[0] * h1[0] + h1[1] * h1[1]) + (h1[2] * h1[2] + h1[3] * h1[3])); }
                ss += __shfl_xor(ss, 16); ss += __shfl_xor(ss, 32);
                if (fq == 0) atomicAdd(sumsq + row, ss);
                if (m & 1) asm volatile("" ::: "memory"); }
        return false;
    }
};
struct EpiSwiglu {
    static constexpr bool PERM = true;
    const float* sumsq; bf16_t* ACT;
    struct Pre { float ss[2][4]; };
    __device__ __forceinline__ Pre prefetch(const Unit& u, int wr, int wc, int fr, int fq) const { Pre r; const int row0 = u.pm * BM + wr * 64 + fr;
#pragma unroll
        for (int ai = 0; ai < 2; ++ai)
#pragma unroll
            for (int m = 0; m < 4; ++m) r.ss[ai][m] = sumsq[row0 + ai * HALF + m * 16];
        return r; }
    __device__ __forceinline__ bool operator()(f32x4 (&acc)[2][2][4][2], const Unit& u, int wr, int wc, int fr, int fq, const Pre& pre) const {
        const int row0 = u.pm * BM + wr * 64 + fr, acol0 = u.pn * HALF + wc * 32 + 8 * fq;
#pragma unroll
        for (int ai = 0; ai < 2; ++ai)
#pragma unroll
            for (int m = 0; m < 4; ++m) { const int row = row0 + ai * HALF + m * 16;
                const float rstd = rsqrtf(pre.ss[ai][m] * (1.f / DM) + RMS_EPS);
                f32x4 a0, a1;
#pragma unroll
                for (int e = 0; e < 4; ++e) { const float g0 = acc[ai][0][m][0][e] * rstd, g1 = acc[ai][0][m][1][e] * rstd;
                    a0[e] = g0 * fast_sigmoid(g0) * (acc[ai][1][m][0][e] * rstd); a1[e] = g1 * fast_sigmoid(g1) * (acc[ai][1][m][1][e] * rstd); }
                *(u32x4*)(ACT + (size_t)row * DFF + acol0 + (u.pm >= ACT_GAP_FROM ? ACT_GAP / 2 : (size_t)0)) = pack8(a0, a1); }
        return false;
    }
};
struct EpiDown {
    static constexpr bool PERM = true;
    struct Pre {}; __device__ __forceinline__ Pre prefetch(const Unit&, int, int, int, int) const { return Pre{}; }
    float* out; const bf16_t* H1B;
    __device__ __forceinline__ bool operator()(f32x4 (&acc)[2][2][4][2], const Unit& u, int wr, int wc, int fr, int fq, const Pre&) const {
        const int row0 = u.pm * BM + wr * 64 + fr, col0 = u.pn * BM + wc * 64 + 8 * fq;
#pragma unroll
        for (int ai = 0; ai < 2; ++ai)
#pragma unroll
            for (int m = 0; m < 4; ++m) { const size_t off = (size_t)(row0 + ai * HALF + m * 16) * DM + col0;
#pragma unroll
                for (int bj = 0; bj < 2; ++bj) { const size_t o = off + bj * 32; const u32x4 w = *(const u32x4*)(H1B + o);
                    *(f32x4*)(out + o) = (f32x4){bflo(w.x), bfhi(w.x), bflo(w.y), bfhi(w.y)} + acc[ai][bj][m][0];
                    *(f32x4*)(out + o + 4) = (f32x4){bflo(w.z), bfhi(w.z), bflo(w.w), bfhi(w.w)} + acc[ai][bj][m][1]; }
                if (m & 1) asm volatile("" ::: "memory"); }
        return false;
    }
};

template <class Epi, class Sched>
__device__ __forceinline__ void gemm_phase(PG8_LAS unsigned char* lds, const Gemm g, const Sched& S, const Epi& E) {
    const int tid = opaque_tid(), wid = __builtin_amdgcn_readfirstlane(tid >> 6), lane = tid & 63, wr = wid >> 2, wc = wid & 3, fr = lane & 15, fq = lane >> 4;
    const int nt = g.nt;
    unsigned voffA[2], voffB[2];
#pragma unroll
    for (int i = 0; i < 2; ++i) { int R, C; stage_rc(tid * 16 + i * 8192, R, C); const int Rb = Epi::PERM ? ((R & ~31) + perm32(R & 31)) : R;
        voffA[i] = (unsigned)(R * g.lda + C) * 2u; voffB[i] = (unsigned)(Rb * g.ldb + C) * 2u; }
    const unsigned kstep = (unsigned)(BK * 2);
    const unsigned hstepA = (unsigned)HALF * g.lda * 2, hstepB = (unsigned)HALF * g.ldb * 2;
    const unsigned tstepA = 2 * hstepA, tstepB = 2 * hstepB;
    const __amdgpu_buffer_rsrc_t rsA = __builtin_amdgcn_make_buffer_rsrc((void*)g.A, 0, -1, 0x00020000);
    const __amdgpu_buffer_rsrc_t rsB = __builtin_amdgcn_make_buffer_rsrc((void*)g.Bt, 0, -1, 0x00020000);
    const unsigned ldsw = (unsigned)wid * 1024u;
    const int aoff = lds_byte(wr * 64 + fr, fq * 8), boff = lds_byte(wc * 32 + fr, fq * 8);
#define PG8_SA(b, h) (((b) * 2 + (h)) * HTB)
#define PG8_SB(b, h) ((4 + (b) * 2 + (h)) * HTB)
#define PG8_STAGE(bufoff, rs, soff, voff) do { _Pragma("unroll") for (int _i = 0; _i < 2; ++_i) \
        __builtin_amdgcn_raw_ptr_buffer_load_lds(rs, (PG8_LAS unsigned*)(lds + (bufoff) + ldsw + _i * 8192), 16, (int)(voff)[_i], (int)(soff), 0, 0); } while (0)
#define PG8_LDA(dst, b, h) do { _Pragma("unroll") for (int m = 0; m < 4; ++m) _Pragma("unroll") for (int k = 0; k < 2; ++k) dst[m][k] = *(const PG8_LAS bf16x8*)(lds + PG8_SA(b, h) + aoff + m * 2048 + k * 1024); } while (0)
#define PG8_LDB(dst, b, h) do { _Pragma("unroll") for (int n = 0; n < 2; ++n) _Pragma("unroll") for (int k = 0; k < 2; ++k) dst[n][k] = *(const PG8_LAS bf16x8*)(lds + PG8_SB(b, h) + boff + n * 2048 + k * 1024); } while (0)
#define PG8_MMA(ai, bj, At, Bt) do { __builtin_amdgcn_s_setprio(1); _Pragma("unroll") for (int m = 0; m < 4; ++m) _Pragma("unroll") for (int n = 0; n < 2; ++n) _Pragma("unroll") for (int k = 0; k < 2; ++k) \
        acc[ai][bj][m][n] = __builtin_amdgcn_mfma_f32_16x16x32_bf16(Bt[n][k], At[m][k], acc[ai][bj][m][n], 0, 0, 0); __builtin_amdgcn_s_setprio(0); } while (0)
#define PG8_WAIT_V(n) asm volatile("s_waitcnt vmcnt(" #n ")" ::: "memory")
#define PG8_WAIT_L(n) asm volatile("s_waitcnt lgkmcnt(" #n ")" ::: "memory")
#define PG8_BAR __builtin_amdgcn_s_barrier()
#define PG8_SCHED __builtin_amdgcn_sched_barrier(0)
    Unit cur, nxt; int ui = 0;
    if (!S.next(0, cur)) return;
    f32x4 acc[2][2][4][2];
#pragma unroll
    for (int a = 0; a < 2; ++a)
#pragma unroll
        for (int b = 0; b < 2; ++b)
#pragma unroll
            for (int m = 0; m < 4; ++m)
#pragma unroll
                for (int n = 0; n < 2; ++n) acc[a][b][m][n] = (f32x4){0.f, 0.f, 0.f, 0.f};
    bf16x8 At[4][2], B0[2][2], B1[2][2];
    typename Epi::Pre pre = E.prefetch(cur, wr, wc, fr, fq);
    unsigned cA = (unsigned)cur.pm * tstepA + (unsigned)cur.pass * g.kpass * 2 + (cur.pm >= g.gapFrom ? g.gapA : 0u), cB = (unsigned)cur.pn * tstepB + (unsigned)cur.pass * g.kpass * 2;
    PG8_STAGE(PG8_SB(0, 0), rsB, cB, voffB); PG8_STAGE(PG8_SB(0, 1), rsB, cB + hstepB, voffB); PG8_STAGE(PG8_SA(0, 0), rsA, cA, voffA); PG8_STAGE(PG8_SA(0, 1), rsA, cA + hstepA, voffA);
    if (wr == 1) PG8_BAR;
    PG8_WAIT_V(2); PG8_BAR;
    PG8_STAGE(PG8_SB(1, 0), rsB, cB + kstep, voffB); PG8_STAGE(PG8_SA(1, 0), rsA, cA + kstep, voffA); PG8_STAGE(PG8_SB(1, 1), rsB, cB + hstepB + kstep, voffB);
    PG8_WAIT_V(6); PG8_BAR;
    for (;;) {
        const bool has_next = S.next(ui + 1, nxt);
        const unsigned nA = has_next ? (unsigned)nxt.pm * tstepA + (unsigned)nxt.pass * g.kpass * 2 + (nxt.pm >= g.gapFrom ? g.gapA : 0u) : cA;
        const unsigned nB = has_next ? (unsigned)nxt.pn * tstepB + (unsigned)nxt.pass * g.kpass * 2 : cB;
        for (int t = 0; t < nt; t += 2) {
            const bool last = (t == nt - 2);
            const unsigned a1 = cA + (unsigned)(t + 1) * kstep;
            const unsigned a2 = last ? nA : cA + (unsigned)(t + 2) * kstep, b2 = last ? nB : cB + (unsigned)(t + 2) * kstep;
            const unsigned a3 = a2 + kstep, b3 = b2 + kstep;
            PG8_LDB(B0, 0, 0); PG8_LDB(B1, 0, 1); PG8_SCHED; PG8_LDA(At, 0, 0); PG8_STAGE(PG8_SA(1, 1), rsA, a1 + hstepA, voffA);
            PG8_WAIT_V(8); PG8_WAIT_L(0); PG8_BAR; PG8_MMA(0, 0, At, B0); PG8_MMA(0, 1, At, B1); PG8_BAR; PG8_SCHED;
            PG8_LDA(At, 0, 1); PG8_STAGE(PG8_SB(0, 0), rsB, b2, voffB); PG8_STAGE(PG8_SB(0, 1), rsB, b2 + hstepB, voffB); PG8_STAGE(PG8_SA(0, 0), rsA, a2, voffA);
            PG8_WAIT_V(8); PG8_WAIT_L(0); PG8_BAR; PG8_MMA(1, 0, At, B0); PG8_MMA(1, 1, At, B1); PG8_BAR; PG8_SCHED;
            PG8_LDB(B0, 1, 0); PG8_LDB(B1, 1, 1); PG8_SCHED; PG8_LDA(At, 1, 0); PG8_STAGE(PG8_SA(0, 1), rsA, a2 + hstepA, voffA);
            PG8_WAIT_V(8); PG8_WAIT_L(0); PG8_BAR; PG8_MMA(0, 0, At, B0); PG8_MMA(0, 1, At, B1); PG8_BAR; PG8_SCHED;
            PG8_LDA(At, 1, 1); PG8_STAGE(PG8_SB(1, 0), rsB, b3, voffB); PG8_STAGE(PG8_SB(1, 1), rsB, b3 + hstepB, voffB); PG8_STAGE(PG8_SA(1, 0), rsA, a3, voffA);
            PG8_WAIT_V(8); PG8_WAIT_L(0); PG8_BAR; PG8_MMA(1, 0, At, B0); PG8_MMA(1, 1, At, B1); PG8_BAR; PG8_SCHED;
        }
        if (wr == 0) PG8_BAR;
        const bool keep = E(acc, cur, wr, wc, fr, fq, pre);
        if (has_next) pre = E.prefetch(nxt, wr, wc, fr, fq);
        if (!has_next) break;
        if (!keep) {
#pragma unroll
            for (int a = 0; a < 2; ++a)
#pragma unroll
                for (int b = 0; b < 2; ++b)
#pragma unroll
                    for (int m = 0; m < 4; ++m)
#pragma unroll
                        for (int n = 0; n < 2; ++n) acc[a][b][m][n] = (f32x4){0.f, 0.f, 0.f, 0.f};
        }
        cur = nxt; cA = nA; cB = nB; ++ui;
        if (wr == 1) PG8_BAR;
    }
    PG8_WAIT_V(0);
    PG8_BAR;
#undef PG8_SA
#undef PG8_SB
#undef PG8_STAGE
#undef PG8_LDA
#undef PG8_LDB
#undef PG8_MMA
#undef PG8_WAIT_V
#undef PG8_WAIT_L
#undef PG8_BAR
#undef PG8_SCHED
}
}

namespace att {
#define ATT_LAS __attribute__((address_space(3)))
typedef float f32x16 __attribute__((ext_vector_type(16)));
typedef short s16x4 __attribute__((ext_vector_type(4)));
constexpr float NEG = -1.0e30f;
constexpr float SHIFT = 12.0f;
template <int D> struct Cfg {
    static constexpr int KP = D * 2 + 16;
    static constexpr int VP = (D == 128) ? 320 : 192;
    static constexpr int KBYTES = 64 * KP, VBYTES = 64 * VP, STG = KBYTES + VBYTES;
    static constexpr int NKS = D / 16, NDB = D / 32, NCH = D / 8, PPT = (64 * NCH) / NTHREADS;
};
__device__ __forceinline__ s16x4 vtr(const ATT_LAS unsigned char* p) { return __builtin_bit_cast(s16x4, __builtin_amdgcn_ds_read_tr16_b64_v4i16((ATT_LAS s16x4*)p)); }

template <int D, bool MOBA>
__device__ __forceinline__ void attn_unit(ATT_LAS unsigned char* lds, const Params& p, int b, int hg, int blk) {
    typedef Cfg<D> C;
    const int tid = opaque_tid(), lane = tid & 63, wave = __builtin_amdgcn_readfirstlane(tid >> 6), q = lane & 31, hi = lane >> 5;
    unsigned char* ws = p.ws;
    const int seqbase = b * SEQ;
    const int qpos0 = MOBA ? 256 * blk : 64 * blk;
    const int t = MOBA ? qpos0 + 32 * wave + q : qpos0 + 32 * (wave & 1) + q;
    const int head = MOBA ? hg : 4 * hg + (wave >> 1);
    const size_t row = (size_t)(seqbase + t);
    const bf16_t* Qrow = MOBA ? (const bf16_t*)(ws + WS_QB) + row * 1024 + head * 128 : (const bf16_t*)(ws + WS_QA) + row * 1024 + head * 64;
    const int kvpitch = MOBA ? 1024 : 256;
    const bf16_t* Kp = (MOBA ? (const bf16_t*)(ws + WS_KB) : (const bf16_t*)(ws + WS_KA)) + (size_t)seqbase * kvpitch + hg * D;
    const bf16_t* Vp = (MOBA ? (const bf16_t*)(ws + WS_VB) : (const bf16_t*)(ws + WS_VA)) + (size_t)seqbase * kvpitch + hg * D;
    bf16_t* Orow = (bf16_t*)(ws + WS_XN) + row * 2048 + (MOBA ? 1024 + head * 128 : head * 64);
    const float slope2 = (MOBA ? exp2f(-(float)(head + 1)) : exp2f(-0.5f * (float)(head + 1))) * LOG2E;

    bf16x8 qf[C::NKS];
#pragma unroll
    for (int ks = 0; ks < C::NKS; ++ks) qf[ks] = *(const bf16x8*)(Qrow + 16 * ks + 8 * hi);

    if constexpr (MOBA) {
        float ssq = 0.f;
#pragma unroll
        for (int ks = 0; ks < C::NKS; ++ks) { float f[8]; unpack8(__builtin_bit_cast(u32x4, qf[ks]), f);
#pragma unroll
            for (int j = 0; j < 8; ++j) ssq += f[j] * f[j]; }
        ssq += __shfl_xor(ssq, 32);
        const float rs = rsqrtf(ssq * (1.f / 128.f) + RMS_EPS) * SC_QB;
#pragma unroll
        for (int ks = 0; ks < C::NKS; ++ks) { float f[8]; unpack8(__builtin_bit_cast(u32x4, qf[ks]), f);
            const f32x4 g0 = *(const f32x4*)(p.qnb + 16 * ks + 8 * hi), g1 = *(const f32x4*)(p.qnb + 16 * ks + 8 * hi + 4);
            u32x4 w; w.x = pg8::cvt_pk_bf16(f[0] * rs * g0[0], f[1] * rs * g0[1]); w.y = pg8::cvt_pk_bf16(f[2] * rs * g0[2], f[3] * rs * g0[3]);
            w.z = pg8::cvt_pk_bf16(f[4] * rs * g1[0], f[5] * rs * g1[1]); w.w = pg8::cvt_pk_bf16(f[6] * rs * g1[2], f[7] * rs * g1[3]);
            qf[ks] = __builtin_bit_cast(bf16x8, w); }
    }
    unsigned selbits = 0u;
    if constexpr (MOBA) {
        if (blk > 0) {
            const int* kmean = (const int*)(ws + WS_KMEAN) + (size_t)(b * 8) * 1024 + head * 128 + 8 * hi;
            float gt[8];
#pragma unroll
            for (int n = 0; n < 7; ++n) {
                float g = -INFINITY;
                if (n < blk) {
                    float part = 0.f;
#pragma unroll
                    for (int ks = 0; ks < 8; ++ks) {
                        const int4 k0 = *(const int4*)(kmean + n * 1024 + 16 * ks), k1 = *(const int4*)(kmean + n * 1024 + 16 * ks + 4);
                        const u32x4 qw = __builtin_bit_cast(u32x4, qf[ks]);
                        part += bflo(qw.x) * (float)k0.x + bfhi(qw.x) * (float)k0.y + bflo(qw.y) * (float)k0.z + bfhi(qw.y) * (float)k0.w
                              + bflo(qw.z) * (float)k1.x + bfhi(qw.z) * (float)k1.y + bflo(qw.w) * (float)k1.z + bfhi(qw.w) * (float)k1.w;
                    }
                    g = part + __shfl_xor(part, 32);
                }
                gt[n] = g;
            }
            gt[7] = -INFINITY;
#pragma unroll
            for (int n = 0; n < 7; ++n) {
                int rank = 0;
#pragma unroll
                for (int n2 = 0; n2 < 7; ++n2) if (n2 != n) rank += (n2 < blk && (gt[n2] > gt[n] || (gt[n2] == gt[n] && n2 < n))) ? 1 : 0;
                if (n < blk && rank < 3) selbits |= (1u << n);
            }
        }
    }

    f32x16 O[C::NDB];
#pragma unroll
    for (int db = 0; db < C::NDB; ++db)
#pragma unroll
        for (int r = 0; r < 16; ++r) O[db][r] = 0.f;
    float l = 0.f;

    const int T = MOBA ? 4 * (blk + 1) : (blk >= 2 ? 3 : blk + 1);
#define ATT_KPOS(i) (MOBA ? ((i) < 4 ? 256 * blk + 64 * (i) : 256 * (((i) - 4) >> 2) + 64 * (((i) - 4) & 3)) : qpos0 - 64 * (i))
    u32x4 kreg[C::PPT], vreg[C::PPT];
    const int prow = tid / C::NCH, pch = tid % C::NCH;
    const unsigned goff = (unsigned)(prow * kvpitch + pch * 8) * 2u;
    const int lk = C::KP * prow + 16 * pch, lv = C::KBYTES + C::VP * prow + 16 * pch;
    constexpr int PR = NTHREADS / C::NCH;
#define ATT_LOAD(kp0) do { const char* _kt = (const char*)(Kp + (size_t)(kp0) * kvpitch); const char* _vt = (const char*)(Vp + (size_t)(kp0) * kvpitch); \
        _Pragma("unroll") for (int _i = 0; _i < C::PPT; ++_i) { kreg[_i] = *(const u32x4*)(_kt + (size_t)_i * PR * kvpitch * 2 + goff); vreg[_i] = *(const u32x4*)(_vt + (size_t)_i * PR * kvpitch * 2 + goff); } } while (0)
#define ATT_WRITE(buf) do { _Pragma("unroll") for (int _i = 0; _i < C::PPT; ++_i) { \
        *(ATT_LAS u32x4*)(lds + (buf) * C::STG + lk + _i * PR * C::KP) = kreg[_i]; *(ATT_LAS u32x4*)(lds + (buf) * C::STG + lv + _i * PR * C::VP) = vreg[_i]; } } while (0)
    const int ka = C::KP * q + 16 * hi;
    const int va = C::VP * (4 * hi + ((lane & 15) >> 2)) + 32 * ((lane >> 4) & 1) + 8 * (lane & 3);
    ATT_LOAD(ATT_KPOS(0)); ATT_WRITE(0); if (T > 1) ATT_LOAD(ATT_KPOS(1)); __syncthreads();
    const int TA = MOBA ? 0 : T;
    for (int i = 0; i < TA; ++i) {
        if (i + 1 < T) ATT_WRITE((i + 1) & 1);
        if (i + 2 < T) ATT_LOAD(ATT_KPOS(i + 2));
        const int kp0 = ATT_KPOS(i);
        int klo = 0, khi = 63;
        if constexpr (MOBA) { khi = t - kp0; }
        else { if (i == 0) khi = t - kp0; if (i == 2) klo = t - 127 - kp0; }
        if (khi > 63) khi = 63; if (klo < 0) klo = 0;
        const bool anyvalid = (khi >= klo);
        if (__any(anyvalid)) {
            const float lbase = slope2 * (float)(kp0 + 4 * hi - t) - SHIFT;
#pragma unroll 1
            for (int hf = 0; hf < 2; ++hf) {
                if (!__any(anyvalid && klo <= 32 * hf + 31 && khi >= 32 * hf)) continue;
                const bool allfull = __all(!anyvalid || (klo <= 32 * hf && khi >= 32 * hf + 31));
                const ATT_LAS unsigned char* Kt = lds + (i & 1) * C::STG + hf * 32 * C::KP;
                const ATT_LAS unsigned char* Vt = lds + (i & 1) * C::STG + C::KBYTES + hf * 32 * C::VP;
                const float lb = anyvalid ? lbase + (float)(32 * hf) * slope2 : NEG;
                f32x16 s;
                if (allfull) {
#pragma unroll
                    for (int r = 0; r < 16; ++r) s[r] = __builtin_fmaf(slope2, (float)((r & 3) + 8 * (r >> 2)), lb);
                } else {
#pragma unroll
                    for (int r = 0; r < 16; ++r) { const int ko = 32 * hf + 4 * hi + (r & 3) + 8 * (r >> 2);
                        s[r] = (ko >= klo && ko <= khi) ? __builtin_fmaf(slope2, (float)((r & 3) + 8 * (r >> 2)), lb) : NEG; }
                }
#pragma unroll
                for (int ks = 0; ks < C::NKS; ++ks) s = __builtin_amdgcn_mfma_f32_32x32x16_bf16(*(const ATT_LAS bf16x8*)(Kt + ka + 32 * ks), qf[ks], s, 0, 0, 0);
                float ls0 = 0.f, ls1 = 0.f, ls2 = 0.f, ls3 = 0.f;
#pragma unroll
                for (int r = 0; r < 16; r += 4) { s[r] = __builtin_amdgcn_exp2f(s[r]); s[r + 1] = __builtin_amdgcn_exp2f(s[r + 1]); s[r + 2] = __builtin_amdgcn_exp2f(s[r + 2]); s[r + 3] = __builtin_amdgcn_exp2f(s[r + 3]);
                    ls0 += s[r]; ls1 += s[r + 1]; ls2 += s[r + 2]; ls3 += s[r + 3]; }
                l += (ls0 + ls1) + (ls2 + ls3);
                bf16x8 pf[2];
#pragma unroll
                for (int ss = 0; ss < 2; ++ss) {
                    u32x4 w;
                    w.x = pg8::cvt_pk_bf16(s[8 * ss + 0], s[8 * ss + 1]); w.y = pg8::cvt_pk_bf16(s[8 * ss + 2], s[8 * ss + 3]); w.z = pg8::cvt_pk_bf16(s[8 * ss + 4], s[8 * ss + 5]); w.w = pg8::cvt_pk_bf16(s[8 * ss + 6], s[8 * ss + 7]);
                    pf[ss] = __builtin_bit_cast(bf16x8, w);
                }
#pragma unroll
                for (int db = 0; db < C::NDB; ++db)
#pragma unroll
                    for (int ss = 0; ss < 2; ++ss) {
                        const s16x4 lo = vtr(Vt + va + 64 * db + C::VP * (16 * ss)), hh = vtr(Vt + va + 64 * db + C::VP * (16 * ss + 8));
                        const bf16x8 vf = (bf16x8){lo[0], lo[1], lo[2], lo[3], hh[0], hh[1], hh[2], hh[3]};
                        O[db] = __builtin_amdgcn_mfma_f32_32x32x16_bf16(vf, pf[ss], O[db], 0, 0, 0);
                    }
            }
        }
        __syncthreads();
    }
    if constexpr (MOBA) {
        auto moba_step = [&](const int i, auto own_tag) __attribute__((always_inline)) {
            constexpr bool OWN = decltype(own_tag)::value;

        if (i + 1 < T) ATT_WRITE((i + 1) & 1);
        if (i + 2 < T) ATT_LOAD(ATT_KPOS(i + 2));
        const int kp0 = ATT_KPOS(i);
        const int khi = t - kp0;
        const bool rowsel = OWN ? (khi >= 0) : (((selbits >> ((i - 4) >> 2)) & 1u) != 0u);
        if (__any(rowsel)) {
            const float lbv = rowsel ? slope2 * (float)(kp0 + 4 * hi - t) - SHIFT : NEG;
            const ATT_LAS unsigned char* Kt = lds + (i & 1) * C::STG;
            const ATT_LAS unsigned char* Vt = lds + (i & 1) * C::STG + C::KBYTES;
            f32x16 s0, s1;
#pragma unroll
            for (int r = 0; r < 16; ++r) { const float cr = (float)((r & 3) + 8 * (r >> 2)); s0[r] = __builtin_fmaf(slope2, cr, lbv); s1[r] = __builtin_fmaf(slope2, cr + 32.f, lbv); }
            if constexpr (OWN) {
#pragma unroll
                for (int r = 0; r < 16; ++r) { const int d0 = khi - (4 * hi + (r & 3) + 8 * (r >> 2));
                    s0[r] += __builtin_bit_cast(float, (d0 >> 31) & 0xF149F2CA);
                    s1[r] += __builtin_bit_cast(float, ((d0 - 32) >> 31) & 0xF149F2CA); }
            }
#pragma unroll
            for (int ks = 0; ks < C::NKS; ++ks) s0 = __builtin_amdgcn_mfma_f32_32x32x16_bf16(*(const ATT_LAS bf16x8*)(Kt + ka + 32 * ks), qf[ks], s0, 0, 0, 0);
            __builtin_amdgcn_sched_barrier(0);
            bf16x8 pf0[2], pf1[2];
            {
#pragma unroll
                for (int ks = 0; ks < C::NKS; ++ks) s1 = __builtin_amdgcn_mfma_f32_32x32x16_bf16(*(const ATT_LAS bf16x8*)(Kt + 32 * C::KP + ka + 32 * ks), qf[ks], s1, 0, 0, 0);
                float ls0 = 0.f, ls1 = 0.f, ls2 = 0.f, ls3 = 0.f;
#pragma unroll
                for (int r = 0; r < 16; r += 4) { s0[r] = __builtin_amdgcn_exp2f(s0[r]); s0[r + 1] = __builtin_amdgcn_exp2f(s0[r + 1]); s0[r + 2] = __builtin_amdgcn_exp2f(s0[r + 2]); s0[r + 3] = __builtin_amdgcn_exp2f(s0[r + 3]);
                    ls0 += s0[r]; ls1 += s0[r + 1]; ls2 += s0[r + 2]; ls3 += s0[r + 3]; }
                l += (ls0 + ls1) + (ls2 + ls3);
#pragma unroll
                for (int ss = 0; ss < 2; ++ss) { u32x4 w;
                    w.x = pg8::cvt_pk_bf16(s0[8 * ss + 0], s0[8 * ss + 1]); w.y = pg8::cvt_pk_bf16(s0[8 * ss + 2], s0[8 * ss + 3]); w.z = pg8::cvt_pk_bf16(s0[8 * ss + 4], s0[8 * ss + 5]); w.w = pg8::cvt_pk_bf16(s0[8 * ss + 6], s0[8 * ss + 7]);
                    pf0[ss] = __builtin_bit_cast(bf16x8, w); }
            }
            __builtin_amdgcn_sched_barrier(0);
            {
#pragma unroll
                for (int db = 0; db < C::NDB; ++db)
#pragma unroll
                    for (int ss = 0; ss < 2; ++ss) {
                        const s16x4 lo = vtr(Vt + va + 64 * db + C::VP * (16 * ss)), hh = vtr(Vt + va + 64 * db + C::VP * (16 * ss + 8));
                        const bf16x8 vf = (bf16x8){lo[0], lo[1], lo[2], lo[3], hh[0], hh[1], hh[2], hh[3]};
                        O[db] = __builtin_amdgcn_mfma_f32_32x32x16_bf16(vf, pf0[ss], O[db], 0, 0, 0);
                    }
                float ls0 = 0.f, ls1 = 0.f, ls2 = 0.f, ls3 = 0.f;
#pragma unroll
                for (int r = 0; r < 16; r += 4) { s1[r] = __builtin_amdgcn_exp2f(s1[r]); s1[r + 1] = __builtin_amdgcn_exp2f(s1[r + 1]); s1[r + 2] = __builtin_amdgcn_exp2f(s1[r + 2]); s1[r + 3] = __builtin_amdgcn_exp2f(s1[r + 3]);
                    ls0 += s1[r]; ls1 += s1[r + 1]; ls2 += s1[r + 2]; ls3 += s1[r + 3]; }
                l += (ls0 + ls1) + (ls2 + ls3);
#pragma unroll
                for (int ss = 0; ss < 2; ++ss) { u32x4 w;
                    w.x = pg8::cvt_pk_bf16(s1[8 * ss + 0], s1[8 * ss + 1]); w.y = pg8::cvt_pk_bf16(s1[8 * ss + 2], s1[8 * ss + 3]); w.z = pg8::cvt_pk_bf16(s1[8 * ss + 4], s1[8 * ss + 5]); w.w = pg8::cvt_pk_bf16(s1[8 * ss + 6], s1[8 * ss + 7]);
                    pf1[ss] = __builtin_bit_cast(bf16x8, w); }
            }
            __builtin_amdgcn_sched_barrier(0);
#pragma unroll
            for (int db = 0; db < C::NDB; ++db)
#pragma unroll
                for (int ss = 0; ss < 2; ++ss) {
                    const s16x4 lo = vtr(Vt + 32 * C::VP + va + 64 * db + C::VP * (16 * ss)), hh = vtr(Vt + 32 * C::VP + va + 64 * db + C::VP * (16 * ss + 8));
                    const bf16x8 vf = (bf16x8){lo[0], lo[1], lo[2], lo[3], hh[0], hh[1], hh[2], hh[3]};
                    O[db] = __builtin_amdgcn_mfma_f32_32x32x16_bf16(vf, pf1[ss], O[db], 0, 0, 0);
                }
            __builtin_amdgcn_sched_barrier(0);
        }
        __syncthreads();
            };
        for (int i = 0; i < 4; ++i) moba_step(i, std::true_type{});
        for (int i = 4; i < T; ++i) moba_step(i, std::false_type{});
    }
#undef ATT_KPOS
#undef ATT_LOAD
#undef ATT_WRITE
    float lt = l + __shfl_xor(l, 32);
    if constexpr (!MOBA) lt += __builtin_amdgcn_exp2f(p.sinks[head] * LOG2E - SHIFT);
    const float inv = 1.0f / lt;
    if constexpr (MOBA) {
        constexpr int OP = 272;
        ATT_LAS unsigned char* tb = lds + wave * (32 * OP);
#pragma unroll
        for (int db = 0; db < C::NDB; ++db)
#pragma unroll
            for (int g = 0; g < 4; ++g) {
                u32x2 w; w.x = pg8::cvt_pk_bf16(O[db][4 * g] * inv, O[db][4 * g + 1] * inv); w.y = pg8::cvt_pk_bf16(O[db][4 * g + 2] * inv, O[db][4 * g + 3] * inv);
                *(ATT_LAS u32x2*)(tb + q * OP + (32 * db + 8 * g + 4 * hi) * 2) = w;
            }
        bf16_t* Ow = (bf16_t*)(ws + WS_XN) + (size_t)(seqbase + qpos0 + 32 * wave) * 2048 + 1024 + head * 128 + 8 * (lane & 15);
#pragma unroll
        for (int j = 0; j < 8; ++j) {
            const int r = 4 * j + (lane >> 4);
            const u32x4 o = *(const ATT_LAS u32x4*)(tb + r * OP + 16 * (lane & 15));
            *(u32x4*)(Ow + (size_t)r * 2048) = o;
        }
        __syncthreads();
    } else {
#pragma unroll
        for (int db = 0; db < C::NDB; ++db)
#pragma unroll
            for (int g = 0; g < 4; ++g) {
                u32x2 w; w.x = pg8::cvt_pk_bf16(O[db][4 * g] * inv, O[db][4 * g + 1] * inv); w.y = pg8::cvt_pk_bf16(O[db][4 * g + 2] * inv, O[db][4 * g + 3] * inv);
                *(u32x2*)(Orow + 32 * db + 8 * g + 4 * hi) = w;
            }
    }
}

__device__ __forceinline__ void swa_phase(ATT_LAS unsigned char* lds, const Params& p, int bid, int nblk) {
    typedef Cfg<64> C;
    constexpr int TILE = C::STG, UBUF = 3 * TILE;
    const int tid = opaque_tid(), lane = tid & 63, wave = __builtin_amdgcn_readfirstlane(tid >> 6), q = lane & 31, hi = lane >> 5;
    unsigned char* ws = p.ws;
    const bf16_t *QA = (const bf16_t*)(ws + WS_QA), *KA = (const bf16_t*)(ws + WS_KA), *VA = (const bf16_t*)(ws + WS_VA);
    bf16_t* OAB = (bf16_t*)(ws + WS_XN);
    const int prow = tid >> 3, pch = tid & 7;
    const int lk = C::KP * prow + 16 * pch, lv = C::KBYTES + C::VP * prow + 16 * pch;
    const int ka = C::KP * q + 16 * hi;
    const int va = C::VP * (4 * hi + ((lane & 15) >> 2)) + 32 * ((lane >> 4) & 1) + 8 * (lane & 3);
    u32x4 kreg[3], vreg[3]; bf16x8 qn[C::NKS];
#define SWA_DEC(u, b_, g_, n_) const int _x##n_ = (u) & 7, _i##n_ = (u) >> 3, _bg##n_ = _x##n_ * 4 + (_i##n_ >> 5); const int b_ = _bg##n_ >> 2, g_ = _bg##n_ & 3, n_ = _i##n_ & 31
#define SWA_LOAD(u) do { SWA_DEC(u, b_, g_, n_); \
        const bf16_t* kt = KA + ((size_t)(b_ * SEQ + 64 * n_ + prow)) * 256 + g_ * 64 + pch * 8; const bf16_t* vt = VA + ((size_t)(b_ * SEQ + 64 * n_ + prow)) * 256 + g_ * 64 + pch * 8; \
        _Pragma("unroll") for (int _i = 0; _i < 3; ++_i) if (_i <= n_) { kreg[_i] = *(const u32x4*)(kt - (size_t)_i * 64 * 256); vreg[_i] = *(const u32x4*)(vt - (size_t)_i * 64 * 256); } \
        const bf16_t* qr = QA + ((size_t)(b_ * SEQ + 64 * n_ + 32 * (wave & 1) + q)) * 1024 + (4 * g_ + (wave >> 1)) * 64; \
        _Pragma("unroll") for (int ks = 0; ks < C::NKS; ++ks) qn[ks] = *(const bf16x8*)(qr + 16 * ks + 8 * hi); } while (0)
#define SWA_WRITE(u, buf) do { SWA_DEC(u, b_, g_, n_); (void)b_; (void)g_; \
        _Pragma("unroll") for (int _i = 0; _i < 3; ++_i) if (_i <= n_) { *(ATT_LAS u32x4*)(lds + (buf) * UBUF + _i * TILE + lk) = kreg[_i]; *(ATT_LAS u32x4*)(lds + (buf) * UBUF + _i * TILE + lv) = vreg[_i]; } } while (0)
    if (bid >= 1024) return;
    SWA_LOAD(bid); SWA_WRITE(bid, 0); __syncthreads();
    int j = 0;
    for (int u = bid; u < 1024; u += nblk, ++j) {
        bf16x8 qf[C::NKS];
#pragma unroll
        for (int ks = 0; ks < C::NKS; ++ks) qf[ks] = qn[ks];
        const int un = u + nblk; const bool more = un < 1024;
        if (more) SWA_LOAD(un);
        SWA_DEC(u, b, g, n);
        const int head = 4 * g + (wave >> 1), qpos0 = 64 * n, t = qpos0 + 32 * (wave & 1) + q;
        const float slope2 = exp2f(-0.5f * (float)(head + 1)) * LOG2E;
        f32x16 O[C::NDB];
#pragma unroll
        for (int db = 0; db < C::NDB; ++db)
#pragma unroll
            for (int r = 0; r < 16; ++r) O[db][r] = 0.f;
        float l = 0.f;
        const int sgn = wave & 1;
        const ATT_LAS unsigned char* ub = lds + (j & 1) * UBUF;
#define SWA_HALF(J, GUARD) do { if (!(GUARD) || (J) <= 2 * n + sgn) { \
            const int g_ = 1 - sgn + (J); \
            const ATT_LAS unsigned char* Kt = ub + (g_ >> 1) * TILE + (1 - (g_ & 1)) * 32 * C::KP; \
            const ATT_LAS unsigned char* Vt = ub + (g_ >> 1) * TILE + C::KBYTES + (1 - (g_ & 1)) * 32 * C::VP; \
            const float lb = slope2 * (float)(4 * hi - 32 * (J) - q) - SHIFT; \
            f32x16 s; \
            _Pragma("unroll") for (int r = 0; r < 16; ++r) { const int ko = 4 * hi + (r & 3) + 8 * (r >> 2); const float v = __builtin_fmaf(slope2, (float)((r & 3) + 8 * (r >> 2)), lb); \
                s[r] = ((J) == 0) ? (ko <= q ? v : NEG) : ((J) == 4) ? (ko >= q + 1 ? v : NEG) : v; } \
            _Pragma("unroll") for (int ks = 0; ks < C::NKS; ++ks) s = __builtin_amdgcn_mfma_f32_32x32x16_bf16(*(const ATT_LAS bf16x8*)(Kt + ka + 32 * ks), qf[ks], s, 0, 0, 0); \
            float ls0 = 0.f, ls1 = 0.f, ls2 = 0.f, ls3 = 0.f; \
            _Pragma("unroll") for (int r = 0; r < 16; r += 4) { s[r] = __builtin_amdgcn_exp2f(s[r]); s[r + 1] = __builtin_amdgcn_exp2f(s[r + 1]); s[r + 2] = __builtin_amdgcn_exp2f(s[r + 2]); s[r + 3] = __builtin_amdgcn_exp2f(s[r + 3]); \
                ls0 += s[r]; ls1 += s[r + 1]; ls2 += s[r + 2]; ls3 += s[r + 3]; } \
            l += (ls0 + ls1) + (ls2 + ls3); \
            bf16x8 pf[2]; \
            _Pragma("unroll") for (int ss = 0; ss < 2; ++ss) { u32x4 w; \
                w.x = pg8::cvt_pk_bf16(s[8 * ss + 0], s[8 * ss + 1]); w.y = pg8::cvt_pk_bf16(s[8 * ss + 2], s[8 * ss + 3]); w.z = pg8::cvt_pk_bf16(s[8 * ss + 4], s[8 * ss + 5]); w.w = pg8::cvt_pk_bf16(s[8 * ss + 6], s[8 * ss + 7]); \
                pf[ss] = __builtin_bit_cast(bf16x8, w); } \
            _Pragma("unroll") for (int db = 0; db < C::NDB; ++db) _Pragma("unroll") for (int ss = 0; ss < 2; ++ss) { \
                const s16x4 lo = vtr(Vt + va + 64 * db + C::VP * (16 * ss)), hh = vtr(Vt + va + 64 * db + C::VP * (16 * ss + 8)); \
                const bf16x8 vf = (bf16x8){lo[0], lo[1], lo[2], lo[3], hh[0], hh[1], hh[2], hh[3]}; \
                O[db] = __builtin_amdgcn_mfma_f32_32x32x16_bf16(vf, pf[ss], O[db], 0, 0, 0); } } } while (0)
        if (n >= 2) { SWA_HALF(0, false); SWA_HALF(1, false); SWA_HALF(2, false); SWA_HALF(3, false); SWA_HALF(4, false); }
        else        { SWA_HALF(0, true);  SWA_HALF(1, true);  SWA_HALF(2, true);  SWA_HALF(3, true);  SWA_HALF(4, true); }
#undef SWA_HALF
        const float lt = l + __shfl_xor(l, 32) + __builtin_amdgcn_exp2f(p.sinks[head] * LOG2E - SHIFT);
        const float inv = 1.0f / lt;
        bf16_t* Orow = OAB + (size_t)(b * SEQ + t) * 2048 + head * 64;
#pragma unroll
        for (int db = 0; db < C::NDB; ++db)
#pragma unroll
            for (int gq = 0; gq < 4; ++gq) {
                u32x2 w; w.x = pg8::cvt_pk_bf16(O[db][4 * gq] * inv, O[db][4 * gq + 1] * inv); w.y = pg8::cvt_pk_bf16(O[db][4 * gq + 2] * inv, O[db][4 * gq + 3] * inv);
                *(u32x2*)(Orow + 32 * db + 8 * gq + 4 * hi) = w;
            }
        if (more) SWA_WRITE(un, (j + 1) & 1);
        __syncthreads();
    }
#undef SWA_DEC
#undef SWA_LOAD
#undef SWA_WRITE
}

__device__ __forceinline__ void attn_phase(ATT_LAS unsigned char* lds, const Params& p, int bid, int nblk) {
    for (int uu = 0;; ++uu) {
        const int it = bid + (uu >> 1) * nblk; if (it >= 256) break;
        const int x = it & 7, idx = it >> 3, bh = x * 8 + (idx >> 2), s = idx & 3;
        attn_unit<128, true>(lds, p, bh >> 3, bh & 7, (uu & 1) ? 7 - s : s);
    }
    __syncthreads();
    swa_phase(lds, p, bid, nblk);
}
}

#define XB_TMO      128
#define XB_XCNT(j)  (256  + 64 * (j))
#define XB_XSUB(j)  (1280 + 64 * (j))
#define XB_XGEN(j)  (2304 + 64 * (j))
#define XB_TOP      3328
#define XB_TOPGEN   3392
#define XCD_BAR_WORDS 3456
#define XB_SPIN_CAP (1u << 18)
#define XLAS __attribute__((address_space(3)))
__device__ __forceinline__ unsigned xb_ld(unsigned* p)              { return __hip_atomic_load(p, __ATOMIC_RELAXED, __HIP_MEMORY_SCOPE_AGENT); }
__device__ __forceinline__ unsigned xb_add(unsigned* p, unsigned v) { return __hip_atomic_fetch_add(p, v, __ATOMIC_RELAXED, __HIP_MEMORY_SCOPE_AGENT); }
__device__ __forceinline__ unsigned xb_xcc_id() { return (unsigned)__builtin_amdgcn_s_getreg((3 << 11) | 20) & 0xFu; }
#define XB_SPIN(cond, bar) do { unsigned _sp = 0; while (cond) { __builtin_amdgcn_s_sleep(1); \
    if ((++_sp & 255u) == 0u) { if (xb_ld(&(bar)[XB_TMO])) break; if (_sp > XB_SPIN_CAP) { atomicAdd(&(bar)[XB_TMO], 1u); break; } } } } while (0)
struct XcdBarrier { unsigned* bar; unsigned x; volatile XLAS unsigned* st; };
__device__ __forceinline__ XcdBarrier xcd_barrier_post(unsigned* bar, volatile XLAS unsigned* st) {
    XcdBarrier b; b.bar = bar; b.x = xb_xcc_id(); b.st = st;
    if (threadIdx.x == 0) (void)xb_add(&bar[XB_XCNT(b.x)], 1u);
    return b;
}
__device__ __forceinline__ void xcd_barrier_complete(unsigned* bar, unsigned x, unsigned& nloc, unsigned& nx) {
    const unsigned G = gridDim.x * gridDim.y * gridDim.z;
    unsigned sum, cnt, mine, sp = 0u;
    for (;;) {
        sum = 0u; cnt = 0u; mine = 0u;
#pragma unroll
        for (unsigned j = 0; j < 16; ++j) { const unsigned c = xb_ld(&bar[XB_XCNT(j)]); sum += c; cnt += (c > 0u) ? 1u : 0u; mine = (j == x) ? c : mine; }
        if (sum == G) break;
        __builtin_amdgcn_s_sleep(1);
        if ((++sp & 255u) == 0u) { if (xb_ld(&bar[XB_TMO])) break; if (sp > XB_SPIN_CAP) { atomicAdd(&bar[XB_TMO], 1u); break; } }
    }
    nloc = mine > 0u ? mine : 1u; nx = cnt > 0u ? cnt : 1u;
}
__device__ __forceinline__ void xcd_barrier(const XcdBarrier& b) {
    asm volatile("s_waitcnt vmcnt(0)" ::: "memory");
    __syncthreads();
    if (threadIdx.x == 0) {
        unsigned* bar = b.bar;
        __builtin_amdgcn_s_waitcnt(0);
        unsigned nloc = b.st[0], nx = b.st[1];
        if (nloc == 0u) { xcd_barrier_complete(bar, b.x, nloc, nx); b.st[0] = nloc; b.st[1] = nx; }
        const unsigned old = xb_add(&bar[XB_XSUB(b.x)], 1u);
        const unsigned gen = old / nloc;
        if (old + 1u == (gen + 1u) * nloc) {
            __builtin_amdgcn_fence(__ATOMIC_RELEASE, "agent");
            asm volatile("s_waitcnt vmcnt(0)" ::: "memory");
            const unsigned og = xb_add(&bar[XB_TOP], 1u);
            const unsigned tg = og / nx;
            if (og + 1u == (tg + 1u) * nx) xb_add(&bar[XB_TOPGEN], 1u);
            else XB_SPIN(xb_ld(&bar[XB_TOPGEN]) == tg, bar);
            __builtin_amdgcn_fence(__ATOMIC_ACQUIRE, "agent");
            xb_add(&bar[XB_XGEN(b.x)], 1u);
            asm volatile("s_waitcnt vmcnt(0)" ::: "memory");
        } else {
            XB_SPIN(xb_ld(&bar[XB_XGEN(b.x)]) == gen, bar);
            __builtin_amdgcn_fence(__ATOMIC_ACQUIRE, "agent");
            asm volatile("s_waitcnt vmcnt(0)" ::: "memory");
        }
    }
    __syncthreads();
}

constexpr int LDS_BYTES = 147456, MISC_OFF = 131072 + 320, XCH_OFF = 131072 + 1024;
#define GRID_SYNC() xcd_barrier(xbar)
#define XB_CLUSTER(k) (4096 + 64 * (k))
__device__ __forceinline__ void cluster_barrier(unsigned* bar, int k, unsigned target, bool same_l2) {
    asm volatile("s_waitcnt vmcnt(0)" ::: "memory");
    __syncthreads();
    if (threadIdx.x == 0) {
        if (!same_l2) __builtin_amdgcn_fence(__ATOMIC_RELEASE, "agent");
        asm volatile("s_waitcnt vmcnt(0)" ::: "memory");
        (void)xb_add(&bar[XB_CLUSTER(k)], 1u);
        XB_SPIN(xb_ld(&bar[XB_CLUSTER(k)]) < target, bar);
        __builtin_amdgcn_fence(__ATOMIC_ACQUIRE, "agent");
        asm volatile("s_waitcnt vmcnt(0)" ::: "memory");
    }
    __syncthreads();
}
#ifndef P1_LAG_TICKS
#define P1_LAG_TICKS 1200
#endif
#ifndef PROBE_P0
#define PROBE_P0 1
#endif
#ifndef PROBE_P1
#define PROBE_P1 1
#endif
#ifndef PROBE_P15
#define PROBE_P15 1
#endif
#ifndef PROBE_ATT
#define PROBE_ATT 1
#endif
#ifndef PROBE_P3
#define PROBE_P3 1
#endif
#ifndef PROBE_P5
#define PROBE_P5 1
#endif
__global__ void __launch_bounds__(NTHREADS, 2) fwd_megakernel(Params p) {
    extern __shared__ __attribute__((aligned(16))) unsigned char lds[];
    const int bid = blockIdx.x, nblk = gridDim.x;
    unsigned char* ws = p.ws;
    PG8_LAS unsigned char* ring = (PG8_LAS unsigned char*)lds;
    volatile XLAS unsigned* misc = (volatile XLAS unsigned*)((XLAS unsigned char*)lds + MISC_OFF);
    if (threadIdx.x < 8) misc[threadIdx.x] = 0u;
    __syncthreads();
    const XcdBarrier xbar = xcd_barrier_post((unsigned*)(ws + WS_CTL), misc);
    const bool clustered = (nblk == 256); const int cluster = 8 * (bid & 7) + ((bid >> 3) & 7); const unsigned csize = 4u;
    if (threadIdx.x == 0) __hip_atomic_store((unsigned*)(ws + WS_CTL) + 16384 + bid, xbar.x, __ATOMIC_RELAXED, __HIP_MEMORY_SCOPE_AGENT);
    bool same_l2 = false, same_l2_group = false;
#define GROUP_SYNC(n) do { if (clustered) cluster_barrier((unsigned*)(ws + WS_CTL), 64 + (bid & 7), (unsigned)(n) * 32u, same_l2_group); else GRID_SYNC(); } while (0)
#define SEAM_SYNC(n) do { if (clustered) cluster_barrier((unsigned*)(ws + WS_CTL), cluster, (unsigned)(n) * csize, same_l2); else GRID_SYNC(); } while (0)
    const int n9 = (M / 256) * (NIN / 256) - 8 * nblk; const bool defer_late = (nblk == 256);
    { p0_prologue(p, defer_late, bid, nblk, (P0_LAS unsigned char*)lds); GRID_SYNC(); }
    if (clustered) {
        const unsigned* ids = (const unsigned*)(ws + WS_CTL) + 16384; const int b0 = (bid & 7) + 8 * ((bid >> 3) & 7);
        const unsigned i0 = xb_ld((unsigned*)ids + b0), i1 = xb_ld((unsigned*)ids + b0 + 64), i2 = xb_ld((unsigned*)ids + b0 + 128), i3 = xb_ld((unsigned*)ids + b0 + 192);
        same_l2 = (i0 == i1) && (i1 == i2) && (i2 == i3);
        bool g = true;
        for (int j = 0; j < 32; ++j) g = g && (xb_ld((unsigned*)ids + (bid & 7) + 8 * j) == i0);
        same_l2_group = g;
    }
#if PROBE_P0 > 1
    { p0_prologue(p, defer_late, bid, nblk, (P0_LAS unsigned char*)lds); GRID_SYNC(); }
#endif

    {
        if (defer_late && bid >= n9) { const int lw = (bid - n9) * NWAVES + (threadIdx.x >> 6), LNW = (nblk - n9) * NWAVES;
            p0_weights<1>(p, lw, LNW, (P0_LAS unsigned char*)lds); p0_weights<2>(p, lw, LNW, (P0_LAS unsigned char*)lds); __syncthreads(); }
        pg8::Gemm g{(const bf16_t*)(ws + WS_XN), (const bf16_t*)(ws + WS_WIN), 2048, 2048, 32, 0}; pg8::TileOrder<1> S; S.init(M, NIN, nblk, bid);
        pg8::EpiZ E{ws, p.b_gate, p.qna, p.kna, p.knb, (PG8_LAS float*)((PG8_LAS unsigned char*)lds + XCH_OFF)}; pg8::gemm_phase(ring, g, S, E); GROUP_SYNC(1); }
#if PROBE_P1 > 1
    {
        pg8::Gemm g{(const bf16_t*)(ws + WS_XN), (const bf16_t*)(ws + WS_WIN), 2048, 2048, 32, 0}; pg8::TileOrder<1> S; S.init(M, NIN, nblk, bid);
        pg8::EpiZ E{ws, p.b_gate, p.qna, p.kna, p.knb, (PG8_LAS float*)((PG8_LAS unsigned char*)lds + XCH_OFF)}; pg8::gemm_phase(ring, g, S, E); GRID_SYNC(); }
#endif

    { att::attn_phase((ATT_LAS unsigned char*)lds, p, bid, nblk); GRID_SYNC(); }
#if PROBE_ATT > 1
    { att::attn_phase((ATT_LAS unsigned char*)lds, p, bid, nblk); GRID_SYNC(); }
#endif

    {
        pg8::Gemm g{(const bf16_t*)(ws + WS_XN), (const bf16_t*)(ws + WS_WAB), 2048, 2048, 16, 1024}; pg8::TileOrder<2> S; S.init(M, DM, nblk, bid);
        pg8::EpiMixed E{(const bf16_t*)(ws + WS_GATES), (bf16_t*)(ws + WS_MIXED)}; pg8::gemm_phase(ring, g, S, E); SEAM_SYNC(1); }

    { pg8::Gemm g{(const bf16_t*)(ws + WS_MIXED), (const bf16_t*)(ws + WS_WO), 4096, 2048, 32, 0}; pg8::TileOrder<1> S; S.init(M, DM, nblk, bid);
      pg8::EpiWo E{p.x, p.out, (bf16_t*)(ws + WS_XN), (float*)(ws + WS_SUMSQ)}; pg8::gemm_phase(ring, g, S, E); }
    SEAM_SYNC(2);
    {
        pg8::Gemm g{(const bf16_t*)(ws + WS_XN), (const bf16_t*)(ws + WS_WGU), 2048, 2048, 32, 0}; pg8::TileOrder<1> S; S.init(M, 2 * DFF, nblk, bid);
        pg8::EpiSwiglu E{(const float*)(ws + WS_SUMSQ), (bf16_t*)(ws + WS_ACT)}; pg8::gemm_phase(ring, g, S, E); SEAM_SYNC(3); }

    { pg8::Gemm g{(const bf16_t*)(ws + WS_ACT), (const bf16_t*)(ws + WS_WD), DFF, DFF, DFF / 64, 0, (unsigned)ACT_GAP, ACT_GAP_FROM}; pg8::TileOrder<1> S; S.init(M, DM, nblk, bid);
      pg8::EpiDown E{p.out, (const bf16_t*)(ws + WS_XN)}; pg8::gemm_phase(ring, g, S, E); }
}

extern "C" void kernel_launch(void* const* d_in, const int* in_sizes, int n_in, void* d_out, int out_size, void* d_ws, size_t ws_size, hipStream_t stream) {
    if (n_in != 16 || ws_size < WS_END) { fprintf(stderr, "kernel_launch: unexpected n_in %d / ws_size %zu\n", n_in, ws_size); return; }
    static int grid_blocks = 0;
    if (!grid_blocks) {
        int dev = 0, cus = 0, per_cu = 0;
        (void)hipGetDevice(&dev);
        (void)hipDeviceGetAttribute(&cus, hipDeviceAttributeMultiprocessorCount, dev);
        (void)hipFuncSetAttribute((const void*)fwd_megakernel, hipFuncAttributeMaxDynamicSharedMemorySize, LDS_BYTES);
        (void)hipOccupancyMaxActiveBlocksPerMultiprocessor(&per_cu, (const void*)fwd_megakernel, NTHREADS, LDS_BYTES);
        if (per_cu < 1) per_cu = 1;
        grid_blocks = cus * per_cu;
        fprintf(stderr, "kernel_launch: cus %d per_cu %d grid %d\n", cus, per_cu, grid_blocks);
    }
    Params p{};
    p.x = (const float*)d_in[0]; p.norm1_g = (const float*)d_in[1]; p.w_in = (const float*)d_in[2]; p.b_gate = (const float*)d_in[3];
    p.qna = (const float*)d_in[4]; p.kna = (const float*)d_in[5]; p.sinks = (const float*)d_in[6]; p.qnb = (const float*)d_in[7]; p.knb = (const float*)d_in[8];
    p.wba = (const float*)d_in[9]; p.wbb = (const float*)d_in[10]; p.wo = (const float*)d_in[11]; p.norm2_g = (const float*)d_in[12];
    p.wg = (const float*)d_in[13]; p.wu = (const float*)d_in[14]; p.wd = (const float*)d_in[15];
    p.out = (float*)d_out; p.ws = (unsigned char*)d_ws;
    (void)hipMemsetAsync((char*)d_ws + WS_CTL, 0, 65536, stream);
    void* args[] = {&p};
    hipError_t e = hipLaunchCooperativeKernel((const void*)fwd_megakernel, dim3(grid_blocks), dim3(NTHREADS), args, LDS_BYTES, stream);
    if (e != hipSuccess) fprintf(stderr, "cooperative launch failed: %s (grid %d)\n", hipGetErrorString(e), grid_blocks);
}
```

```cpp
#include <hip/hip_runtime.h>
#include <stdint.h>
#include <type_traits>
#include <cstdio>

typedef unsigned short bf16_t;
typedef short bf16x8 __attribute__((ext_vector_type(8)));
typedef float f32x4 __attribute__((ext_vector_type(4)));
typedef unsigned u32x4 __attribute__((ext_vector_type(4)));
typedef unsigned u32x2 __attribute__((ext_vector_type(2)));

constexpr int BATCH = 8, SEQ = 2048, DM = 2048, M = BATCH * SEQ;
constexpr int NIN = 8704, DFF = 5632;
constexpr int C_QA = 0, C_KA = 1024, C_VA = 1280, C_QB = 1536, C_KB = 2560, C_VB = 3584, C_G = 4608;
constexpr float RMS_EPS = 1e-6f;
constexpr float LOG2E = 1.4426950408889634f;
constexpr float SC_QA = 0.125f * LOG2E, SC_QB = 0.08838834764831845f * LOG2E;
constexpr int NWAVES = 8, NTHREADS = 512;

constexpr size_t MiB = 1u << 20;
constexpr size_t WS_CTL = 0;
constexpr size_t WS_SUMSQ = 1 * MiB;
constexpr size_t WS_KMEAN = 1 * MiB + 128 * 1024;
constexpr size_t WS_WIN = 2 * MiB;
constexpr size_t WS_WAB = 36 * MiB;
constexpr size_t WS_WO = 44 * MiB;
constexpr size_t WS_WGU = 52 * MiB;
constexpr size_t WS_WD = 96 * MiB;
constexpr size_t WS_XN = 118 * MiB;
constexpr size_t WS_QA = 182 * MiB;
constexpr size_t WS_KA = 214 * MiB;
constexpr size_t WS_VA = 222 * MiB;
constexpr size_t WS_QB = 230 * MiB;
constexpr size_t WS_KB = 262 * MiB;
constexpr size_t WS_VB = 294 * MiB;
constexpr size_t WS_GATES = 326 * MiB;
constexpr size_t WS_MIXED = WS_GATES;
constexpr size_t WS_ACT = 182 * MiB;
constexpr int    ACT_GAP_FROM = 52;
constexpr size_t ACT_GAP = (454 - 182) * MiB - (size_t)ACT_GAP_FROM * 256 * 5632 * 2;
constexpr size_t WS_END = 487 * MiB;

struct Params {
    const float *x, *norm1_g, *w_in, *b_gate, *qna, *kna, *sinks, *qnb, *knb, *wba, *wbb, *wo, *norm2_g, *wg, *wu, *wd;
    float* out; unsigned char* ws;
};

__device__ __forceinline__ int opaque_tid() { int t = threadIdx.x; asm volatile("" : "+v"(t)); return t; }
__device__ __forceinline__ unsigned f2bf(float f) { unsigned u = __builtin_bit_cast(unsigned, f); return (u + 0x7fffu + ((u >> 16) & 1u)) >> 16; }
__device__ __forceinline__ unsigned pk2(float lo, float hi) { return f2bf(lo) | (f2bf(hi) << 16); }
__device__ __forceinline__ float bf2f(unsigned short b) { return __builtin_bit_cast(float, (unsigned)b << 16); }
__device__ __forceinline__ float bflo(unsigned w) { return __builtin_bit_cast(float, w << 16); }
__device__ __forceinline__ float bfhi(unsigned w) { return __builtin_bit_cast(float, w & 0xffff0000u); }
__device__ __forceinline__ float wave_sum(float v) {
#pragma unroll
    for (int o = 1; o < 64; o <<= 1) v += __shfl_xor(v, o);
    return v;
}
__device__ __forceinline__ float wave_max(float v) {
#pragma unroll
    for (int o = 1; o < 64; o <<= 1) v = fmaxf(v, __shfl_xor(v, o));
    return v;
}

typedef float f32x2_t __attribute__((ext_vector_type(2))); typedef __bf16 bf16x2_t __attribute__((ext_vector_type(2)));
__device__ __forceinline__ unsigned cvt2(float lo, float hi) { f32x2_t v = {lo, hi}; bf16x2_t b = __builtin_convertvector(v, bf16x2_t); return __builtin_bit_cast(unsigned, b); }
#define P0_LAS __attribute__((address_space(3)))
__device__ __forceinline__ int p0_drow(int n, int mapk) {
    if (mapk == 0) return n;
    if (mapk == 3 || (mapk == 4 && n < C_G)) return (n & ~255) + 128 * ((n >> 5) & 1) + 32 * ((n >> 6) & 3) + (n & 31);
    if (mapk == 4) { const int g = (n >= C_G + 2048) ? 1 : 0, c = n - C_G - 2048 * g; return C_G + 256 * (c >> 7) + 128 * g + (c & 127); }
    return 256 * (n >> 7) + (n & 127) + (mapk == 2 ? 128 : 0);
}
struct WItem { const float* src; const float* ks; bf16_t* d; int ldw, ldd, n0, mapk; };
__device__ __forceinline__ WItem p0_mk(const float* W, int ldw, int n0, int k0, const float* kscale, bf16_t* dst, int ldd, int dstk0, int mapk, int lane) {
    const int l = lane & 31, h = lane >> 5;
    WItem it; it.src = W + (size_t)(k0 + 16 * h) * ldw + n0 + 4 * l; it.ks = kscale ? kscale + k0 + 16 * h : nullptr;
    it.d = dst + dstk0 + k0 + 8 * (lane & 7); it.ldw = ldw; it.ldd = ldd; it.n0 = n0; it.mapk = mapk; return it;
}
__device__ __forceinline__ void p0_ld(const WItem& it, int b, f32x4 (&v)[16]) {
#pragma unroll
    for (int i = 0; i < 16; ++i) v[i] = __builtin_nontemporal_load((const f32x4*)(it.src + (size_t)(32 * b + i) * it.ldw));
}
__device__ __forceinline__ void p0_tolds(const WItem& it, int b, f32x4 (&v)[16], P0_LAS unsigned char* buf, int lane) {
    if (it.ks) {
#pragma unroll
        for (int i = 0; i < 16; ++i) v[i] = v[i] * it.ks[32 * b + i];
    }
    const int l = lane & 31, h = lane >> 5;
#pragma unroll
    for (int e = 0; e < 4; ++e)
#pragma unroll
        for (int q = 0; q < 2; ++q) {
            u32x4 o; o.x = cvt2(v[8 * q + 0][e], v[8 * q + 1][e]); o.y = cvt2(v[8 * q + 2][e], v[8 * q + 3][e]); o.z = cvt2(v[8 * q + 4][e], v[8 * q + 5][e]); o.w = cvt2(v[8 * q + 6][e], v[8 * q + 7][e]);
            const int c = 4 * b + 2 * h + q;
            *(P0_LAS u32x4*)(buf + (4 * l + e) * 128 + ((c ^ (l & 7)) << 4)) = o;
        }
}
__device__ __forceinline__ void p0_flush(const WItem& it, P0_LAS unsigned char* buf, int lane) {
#pragma unroll
    for (int j = 0; j < 16; ++j) {
        const int r = 8 * j + (lane >> 3), c = lane & 7;
        const u32x4 o = *(const P0_LAS u32x4*)(buf + r * 128 + ((c ^ ((r >> 2) & 7)) << 4));
        *(u32x4*)(it.d + (size_t)p0_drow(it.n0 + r, it.mapk) * it.ldd) = o;
    }
}
template <int SET> __device__ __forceinline__ int p0_count() { return SET == 0 ? 68 * 32 + 2 * 44 * 32 : SET == 1 ? 2 * 16 * 16 + 16 * 32 : 16 * 88; }
template <int SET> __device__ __forceinline__ WItem p0_decode(const Params& p, int r, int lane) {
    unsigned char* ws = p.ws;
    if (SET == 0) {
        constexpr int I_G = 44 * 32;
        if (r < I_G) return p0_mk(p.wg, DFF, 128 * (r >> 5), 64 * (r & 31), p.norm2_g, (bf16_t*)(ws + WS_WGU), 2048, 0, 1, lane);
        r -= I_G;
        if (r < I_G) return p0_mk(p.wu, DFF, 128 * (r >> 5), 64 * (r & 31), p.norm2_g, (bf16_t*)(ws + WS_WGU), 2048, 0, 2, lane);
        r -= I_G;
        return p0_mk(p.w_in, NIN, 128 * (r >> 5), 64 * (r & 31), nullptr, (bf16_t*)(ws + WS_WIN), 2048, 0, 4, lane);
    } else if (SET == 1) {
        constexpr int I_BA = 16 * 16;
        if (r < I_BA) return p0_mk(p.wba, 2048, 128 * (r >> 4), 64 * (r & 15), nullptr, (bf16_t*)(ws + WS_WAB), 2048, 0, 3, lane);
        r -= I_BA;
        if (r < I_BA) return p0_mk(p.wbb, 2048, 128 * (r >> 4), 64 * (r & 15), nullptr, (bf16_t*)(ws + WS_WAB), 2048, 1024, 3, lane);
        r -= I_BA;
        return p0_mk(p.wo, 2048, 128 * (r >> 5), 64 * (r & 31), nullptr, (bf16_t*)(ws + WS_WO), 2048, 0, 3, lane);
    } else {
        return p0_mk(p.wd, 2048, 128 * (r / 88), 64 * (r % 88), nullptr, (bf16_t*)(ws + WS_WD), DFF, 0, 3, lane);
    }
}
template <int SET>
__device__ __forceinline__ void p0_weights(const Params& p, int gw, int NGW, P0_LAS unsigned char* lds) {
    const int tid = opaque_tid(), lane = tid & 63; const int cnt = p0_count<SET>();
    if (gw >= cnt) return;
    P0_LAS unsigned char* buf = lds + (tid >> 6) * 16384;
    f32x4 va[16], vb[16];
    WItem cur = p0_decode<SET>(p, gw, lane);
    p0_ld(cur, 0, va);
    for (int it = gw; it < cnt; it += NGW) {
        p0_ld(cur, 1, vb);
        p0_tolds(cur, 0, va, buf, lane);
        const bool more = it + NGW < cnt;
        WItem nxt = cur;
        if (more) { nxt = p0_decode<SET>(p, it + NGW, lane); p0_ld(nxt, 0, va); }
        p0_tolds(cur, 1, vb, buf, lane);
        p0_flush(cur, buf, lane);
        cur = nxt;
    }
}

__device__ __forceinline__ void p0_prologue(const Params& p, bool defer_late, int bid, int nblk, P0_LAS unsigned char* lds) {
    const int tid = opaque_tid(), lane = tid & 63, wave = tid >> 6;
    const int gw = bid * NWAVES + wave, NGW = nblk * NWAVES;
    unsigned char* ws = p.ws;
    float* z = (float*)(ws + WS_SUMSQ);
    for (int i = bid * NTHREADS + tid; i < 16384; i += nblk * NTHREADS) z[i] = 0.f;
    int* z2 = (int*)(ws + WS_KMEAN);
    for (int i = bid * NTHREADS + tid; i < 65536; i += nblk * NTHREADS) z2[i] = 0;
    if (!defer_late) { p0_weights<2>(p, gw, NGW, lds); p0_weights<1>(p, gw, NGW, lds); }
    p0_weights<0>(p, gw, NGW, lds);
    bf16_t* XN = (bf16_t*)(ws + WS_XN);
    if (gw < M) {
        f32x4 v[8], w[8];
        { const f32x4* xr = (const f32x4*)(p.x + (size_t)gw * DM) + lane;
#pragma unroll
          for (int j = 0; j < 8; ++j) v[j] = __builtin_nontemporal_load(xr + 64 * j); }
        for (int m = gw; m < M; m += NGW) {
            const bool more = m + NGW < M;
            if (more) { const f32x4* xr = (const f32x4*)(p.x + (size_t)(m + NGW) * DM) + lane;
#pragma unroll
                for (int j = 0; j < 8; ++j) w[j] = __builtin_nontemporal_load(xr + 64 * j); }
            float s = 0.f;
#pragma unroll
            for (int j = 0; j < 8; ++j) s += (v[j].x * v[j].x + v[j].y * v[j].y) + (v[j].z * v[j].z + v[j].w * v[j].w);
            const float rstd = rsqrtf(wave_sum(s) * (1.f / DM) + RMS_EPS);
            u32x2* o8 = (u32x2*)(XN + (size_t)m * DM) + lane;
#pragma unroll
            for (int j = 0; j < 8; ++j) { const f32x4 g = ((const f32x4*)p.norm1_g)[64 * j + lane];
                u32x2 o; o.x = cvt2(v[j].x * rstd * g.x, v[j].y * rstd * g.y); o.y = cvt2(v[j].z * rstd * g.z, v[j].w * rstd * g.w);
                o8[64 * j] = o; }
#pragma unroll
            for (int j = 0; j < 8; ++j) v[j] = w[j];
        }
    }
}

__device__ __forceinline__ void unpack8(const u32x4 w, float (&f)[8]) {
    f[0] = bflo(w.x); f[1] = bfhi(w.x); f[2] = bflo(w.y); f[3] = bfhi(w.y); f[4] = bflo(w.z); f[5] = bfhi(w.z); f[6] = bflo(w.w); f[7] = bfhi(w.w);
}
namespace pg8 {
#define PG8_LAS __attribute__((address_space(3)))
constexpr int BM = 256, BK = 64, HALF = 128, HTB = HALF * BK * 2, STAGE_BYTES = 8 * HTB, NXCD = 8, WGM = 8;
__host__ __device__ __forceinline__ int lds_byte(int r, int c) { const int st = (r >> 4) * 2 + (c >> 5), rr = r & 15, cc = c & 31, ob = rr * 64 + cc * 2; return st * 1024 + (ob ^ (((ob >> 9) & 1) << 5)); }
__host__ __device__ __forceinline__ void stage_rc(int b, int& R, int& C) { const int st = b / 1024, sb = b % 1024, swz = sb ^ (((sb >> 9) & 1) << 5); R = (st >> 1) * 16 + swz / 64; C = (st & 1) * 32 + (swz % 64) / 2; }
__host__ __device__ __forceinline__ int perm32(int rho) { const int n = rho >> 4, i = rho & 15; return 8 * (i >> 2) + 4 * n + (i & 3); }

struct Unit { int pm, pn, pass; };
struct Gemm { const bf16_t* A; const bf16_t* Bt; int lda, ldb, nt, kpass; unsigned gapA; int gapFrom; };

template <int NPASS> struct TileOrder {
    int nM, nN, nwg, G, c;
    __device__ void init(int M_, int N_, int G_, int c_) { nM = M_ / BM; nN = N_ / BM; nwg = nM * nN; G = G_; c = c_; }
    __device__ bool next(int i, Unit& u) const {
        const int ti = i / NPASS; u.pass = i % NPASS;
        const long L = (long)ti * G + c; if (L >= nwg) return false;
        int wgid = (int)L; { const int q = nwg / NXCD, r = nwg % NXCD, xcd = wgid % NXCD, off = wgid / NXCD; wgid = (xcd < r ? xcd * (q + 1) : r * (q + 1) + (xcd - r) * q) + off; }
        const int nig = WGM * nN, gid = wgid / nig, fm = gid * WGM, gsz = (nM - fm) < WGM ? (nM - fm) : WGM;
        u.pm = fm + ((wgid % nig) % gsz); u.pn = (wgid % nig) / gsz;
        u.pn = (u.pn + 4 * (int)(L % NXCD)) % nN;
        return true;
    }
};

__device__ __forceinline__ unsigned cvt_pk_bf16(float lo, float hi) { f32x2_t v = {lo, hi}; bf16x2_t b = __builtin_convertvector(v, bf16x2_t); return __builtin_bit_cast(unsigned, b); }
__device__ __forceinline__ u32x4 pack8(const f32x4 v0, const f32x4 v1) { u32x4 w; w.x = cvt_pk_bf16(v0[0], v0[1]); w.y = cvt_pk_bf16(v0[2], v0[3]); w.z = cvt_pk_bf16(v1[0], v1[1]); w.w = cvt_pk_bf16(v1[2], v1[3]); return w; }
__device__ __forceinline__ float fast_sigmoid(float x) { return __builtin_amdgcn_rcpf(1.0f + __builtin_amdgcn_exp2f(-1.4426950408889634f * x)); }

struct EpiZ {
    static constexpr bool PERM = true;
    struct Pre {}; __device__ __forceinline__ Pre prefetch(const Unit&, int, int, int, int) const { return Pre{}; }
    unsigned char* ws; const float* b_gate; const float* qna; const float* kna; const float* knb; PG8_LAS float* xch;
    __device__ __forceinline__ bool operator()(f32x4 (&acc)[2][2][4][2], const Unit& u, int wr, int wc, int fr, int fq, const Pre&) const {
        const int colt = u.pn * BM, row0 = u.pm * BM + wr * 64 + fr;
        if (colt >= C_KB && colt < C_VB) {
            float ssr[2][4];
#pragma unroll
            for (int ai = 0; ai < 2; ++ai)
#pragma unroll
                for (int m = 0; m < 4; ++m) { float ss = 0.f;
#pragma unroll
                    for (int bj = 0; bj < 2; ++bj)
#pragma unroll
                        for (int n = 0; n < 2; ++n) { const f32x4 v = acc[ai][bj][m][n]; ss += (v[0] * v[0] + v[1] * v[1]) + (v[2] * v[2] + v[3] * v[3]); }
                    ss += __shfl_xor(ss, 16); ss += __shfl_xor(ss, 32); ssr[ai][m] = ss;
                    if (fq == 0) xch[(wr * 4 + wc) * 128 + (ai * 4 + m) * 16 + fr] = ss; }
            asm volatile("s_waitcnt lgkmcnt(0)" ::: "memory"); __builtin_amdgcn_s_barrier(); asm volatile("" ::: "memory");
            const int d0 = 64 * (wc & 1) + 8 * fq;
            f32x4 gv[2][2];
#pragma unroll
            for (int bj = 0; bj < 2; ++bj)
#pragma unroll
                for (int n = 0; n < 2; ++n) gv[bj][n] = *(const f32x4*)(knb + d0 + 32 * bj + 4 * n);
            f32x4 cs[2][2];
#pragma unroll
            for (int bj = 0; bj < 2; ++bj)
#pragma unroll
                for (int n = 0; n < 2; ++n) cs[bj][n] = (f32x4){0.f, 0.f, 0.f, 0.f};
            bf16_t* base = (bf16_t*)(ws + WS_KB); const int col0 = (colt - C_KB) + wc * 64 + 8 * fq;
#pragma unroll
            for (int ai = 0; ai < 2; ++ai)
#pragma unroll
                for (int m = 0; m < 4; ++m) {
                    const float tot = ssr[ai][m] + xch[(wr * 4 + (wc ^ 1)) * 128 + (ai * 4 + m) * 16 + fr];
                    const float rs = rsqrtf(tot * (1.f / 128.f) + RMS_EPS);
                    bf16_t* rowp = base + (size_t)(row0 + ai * HALF + m * 16) * 1024 + col0;
#pragma unroll
                    for (int bj = 0; bj < 2; ++bj) { const f32x4 y0 = acc[ai][bj][m][0] * rs * gv[bj][0], y1 = acc[ai][bj][m][1] * rs * gv[bj][1];
                        cs[bj][0] += y0; cs[bj][1] += y1;
                        *(u32x4*)(rowp + bj * 32) = pack8(y0, y1); } }
            int* km = (int*)(ws + WS_KMEAN) + (size_t)u.pm * 1024 + col0;
#pragma unroll
            for (int bj = 0; bj < 2; ++bj)
#pragma unroll
                for (int n = 0; n < 2; ++n)
#pragma unroll
                    for (int e = 0; e < 4; ++e) { float v = cs[bj][n][e];
                        v += __shfl_xor(v, 1); v += __shfl_xor(v, 2); v += __shfl_xor(v, 4); v += __shfl_xor(v, 8);
                        if (fr == 0) atomicAdd(km + 32 * bj + 4 * n + e, __float2int_rn(v * 262144.f)); }
            return false;
        }
        bf16_t* base; int ldc, cl;
        if (colt < C_KA) { base = (bf16_t*)(ws + WS_QA); ldc = 1024; cl = colt - C_QA; }
        else if (colt < C_VA) { base = (bf16_t*)(ws + WS_KA); ldc = 256; cl = colt - C_KA; }
        else if (colt < C_QB) { base = (bf16_t*)(ws + WS_VA); ldc = 256; cl = colt - C_VA; }
        else if (colt < C_KB) { base = (bf16_t*)(ws + WS_QB); ldc = 1024; cl = colt - C_QB; }
        else if (colt < C_VB) { base = (bf16_t*)(ws + WS_KB); ldc = 1024; cl = colt - C_KB; }
        else if (colt < C_G) { base = (bf16_t*)(ws + WS_VB); ldc = 1024; cl = colt - C_VB; }
        else { base = (bf16_t*)(ws + WS_GATES); ldc = 4096; cl = colt - C_G; }
        const int col0 = cl + wc * 64 + 8 * fq;
        if (colt < C_VA) {
            const float* g = (colt < C_KA) ? qna : kna; const float sc = (colt < C_KA) ? SC_QA : 1.0f;
            f32x4 gv[2][2];
#pragma unroll
            for (int bj = 0; bj < 2; ++bj)
#pragma unroll
                for (int n = 0; n < 2; ++n) gv[bj][n] = *(const f32x4*)(g + 32 * bj + 8 * fq + 4 * n) * sc;
#pragma unroll
            for (int ai = 0; ai < 2; ++ai)
#pragma unroll
                for (int m = 0; m < 4; ++m) { bf16_t* rowp = base + (size_t)(row0 + ai * HALF + m * 16) * ldc + col0;
                    float ss = 0.f;
#pragma unroll
                    for (int bj = 0; bj < 2; ++bj)
#pragma unroll
                        for (int n = 0; n < 2; ++n) { const f32x4 v = acc[ai][bj][m][n]; ss += (v[0] * v[0] + v[1] * v[1]) + (v[2] * v[2] + v[3] * v[3]); }
                    ss += __shfl_xor(ss, 16); ss += __shfl_xor(ss, 32);
                    const float rs = rsqrtf(ss * (1.f / 64.f) + RMS_EPS);
#pragma unroll
                    for (int bj = 0; bj < 2; ++bj) *(u32x4*)(rowp + bj * 32) = pack8(acc[ai][bj][m][0] * rs * gv[bj][0], acc[ai][bj][m][1] * rs * gv[bj][1]); }
        } else if (colt < C_G) {
#pragma unroll
            for (int ai = 0; ai < 2; ++ai)
#pragma unroll
                for (int m = 0; m < 4; ++m) { bf16_t* rowp = base + (size_t)(row0 + ai * HALF + m * 16) * ldc + col0;
#pragma unroll
                    for (int bj = 0; bj < 2; ++bj) *(u32x4*)(rowp + bj * 32) = pack8(acc[ai][bj][m][0], acc[ai][bj][m][1]); }
        } else {
            const int mc0 = ((colt - C_G) >> 1) + wc * 32 + 8 * fq;
            f32x4 ba[2], bb[2];
#pragma unroll
            for (int n = 0; n < 2; ++n) { ba[n] = *(const f32x4*)(b_gate + mc0 + 4 * n); bb[n] = *(const f32x4*)(b_gate + 2048 + mc0 + 4 * n); }
#pragma unroll
            for (int ai = 0; ai < 2; ++ai)
#pragma unroll
                for (int m = 0; m < 4; ++m) { bf16_t* rowp = (bf16_t*)(ws + WS_GATES) + (size_t)(row0 + ai * HALF + m * 16) * 4096 + mc0;
                    f32x4 r0, r1, g0, g1;
#pragma unroll
                    for (int e = 0; e < 4; ++e) {
                        const float ea0 = __builtin_amdgcn_exp2f(-1.4426950408889634f * (acc[ai][0][m][0][e] + ba[0][e])), ea1 = __builtin_amdgcn_exp2f(-1.4426950408889634f * (acc[ai][0][m][1][e] + ba[1][e]));
                        const float eb0 = __builtin_amdgcn_exp2f(-1.4426950408889634f * (acc[ai][1][m][0][e] + bb[0][e])), eb1 = __builtin_amdgcn_exp2f(-1.4426950408889634f * (acc[ai][1][m][1][e] + bb[1][e]));
                        g0[e] = __builtin_amdgcn_rcpf(1.0f + eb0); g1[e] = __builtin_amdgcn_rcpf(1.0f + eb1);
                        r0[e] = (1.0f + eb0) * __builtin_amdgcn_rcpf(1.0f + ea0); r1[e] = (1.0f + eb1) * __builtin_amdgcn_rcpf(1.0f + ea1);
                    }
                    *(u32x4*)(rowp) = pack8(r0, r1); *(u32x4*)(rowp + 2048) = pack8(g0, g1); }
        }
        return false;
    }
};
struct EpiMixed {
    static constexpr bool PERM = true;
    struct Pre {}; __device__ __forceinline__ Pre prefetch(const Unit&, int, int, int, int) const { return Pre{}; }
    const bf16_t* G; bf16_t* MX;
    __device__ __forceinline__ bool operator()(f32x4 (&acc)[2][2][4][2], const Unit& u, int wr, int wc, int fr, int fq, const Pre&) const {
        const int row0 = u.pm * BM + wr * 64 + fr, col0 = u.pn * BM + wc * 64 + 8 * fq;
#pragma unroll
        for (int ai = 0; ai < 2; ++ai)
#pragma unroll
            for (int m = 0; m < 4; ++m) { const size_t row = (size_t)(row0 + ai * HALF + m * 16);
#pragma unroll
                for (int bj = 0; bj < 2; ++bj) { const int col = col0 + bj * 32;
                    const u32x4 gw = *(const u32x4*)(G + row * 4096 + (u.pass == 0 ? 0 : 2048) + col);
                    float gg[8]; unpack8(gw, gg);
                    if (u.pass == 0) {
#pragma unroll
                        for (int e = 0; e < 4; ++e) { acc[ai][bj][m][0][e] *= gg[e]; acc[ai][bj][m][1][e] *= gg[4 + e]; }
                    } else {
                        f32x4 v0, v1;
#pragma unroll
                        for (int e = 0; e < 4; ++e) { v0[e] = acc[ai][bj][m][0][e] * gg[e]; v1[e] = acc[ai][bj][m][1][e] * gg[4 + e]; }
                        *(u32x4*)(MX + row * 4096 + col) = pack8(v0, v1);
                    } } }
        return u.pass == 0;
    }
};
struct EpiWo {
    static constexpr bool PERM = true;
    struct Pre {}; __device__ __forceinline__ Pre prefetch(const Unit&, int, int, int, int) const { return Pre{}; }
    const float* x; float* out; bf16_t* H1B; float* sumsq;
    __device__ __forceinline__ bool operator()(f32x4 (&acc)[2][2][4][2], const Unit& u, int wr, int wc, int fr, int fq, const Pre&) const {
        const int row0 = u.pm * BM + wr * 64 + fr, col0 = u.pn * BM + wc * 64 + 8 * fq;
#pragma unroll
        for (int ai = 0; ai < 2; ++ai)
#pragma unroll
            for (int m = 0; m < 4; ++m) { const int row = row0 + ai * HALF + m * 16; const size_t off = (size_t)row * DM + col0; float ss = 0.f;
#pragma unroll
                for (int bj = 0; bj < 2; ++bj) { const size_t o = off + bj * 32;
                    const f32x4 h0 = *(const f32x4*)(x + o) + acc[ai][bj][m][0], h1 = *(const f32x4*)(x + o + 4) + acc[ai][bj][m][1];
                    *(u32x4*)(H1B + o) = pack8(h0, h1);
                    ss += ((h0[0] * h0[0] + h0[1] * h0[1]) + (h0[2] * h0[2] + h0[3] * h0[3])) + ((h1[0] * h1[0] + h1[1] * h1[1]) + (h1[2] * h1[2] + h1[3] * h1[3])); }
                ss += __shfl_xor(ss, 16); ss += __shfl_xor(ss, 32);
                if (fq == 0) atomicAdd(sumsq + row, ss);
                if (m & 1) asm volatile("" ::: "memory"); }
        return false;
    }
};
struct EpiSwiglu {
    static constexpr bool PERM = true;
    const float* sumsq; bf16_t* ACT;
    struct Pre { float ss[2][4]; };
    __device__ __forceinline__ Pre prefetch(const Unit& u, int wr, int wc, int fr, int fq) const { Pre r; const int row0 = u.pm * BM + wr * 64 + fr;
#pragma unroll
        for (int ai = 0; ai < 2; ++ai)
#pragma unroll
            for (int m = 0; m < 4; ++m) r.ss[ai][m] = sumsq[row0 + ai * HALF + m * 16];
        return r; }
    __device__ __forceinline__ bool operator()(f32x4 (&acc)[2][2][4][2], const Unit& u, int wr, int wc, int fr, int fq, const Pre& pre) const {
        const int row0 = u.pm * BM + wr * 64 + fr, acol0 = u.pn * HALF + wc * 32 + 8 * fq;
#pragma unroll
        for (int ai = 0; ai < 2; ++ai)
#pragma unroll
            for (int m = 0; m < 4; ++m) { const int row = row0 + ai * HALF + m * 16;
                const float rstd = rsqrtf(pre.ss[ai][m] * (1.f / DM) + RMS_EPS);
                f32x4 a0, a1;
#pragma unroll
                for (int e = 0; e < 4; ++e) { const float g0 = acc[ai][0][m][0][e] * rstd, g1 = acc[ai][0][m][1][e] * rstd;
                    a0[e] = g0 * fast_sigmoid(g0) * (acc[ai][1][m][0][e] * rstd); a1[e] = g1 * fast_sigmoid(g1) * (acc[ai][1][m][1][e] * rstd); }
                *(u32x4*)(ACT + (size_t)row * DFF + acol0 + (u.pm >= ACT_GAP_FROM ? ACT_GAP / 2 : (size_t)0)) = pack8(a0, a1); }
        return false;
    }
};
struct EpiDown {
    static constexpr bool PERM = true;
    struct Pre {}; __device__ __forceinline__ Pre prefetch(const Unit&, int, int, int, int) const { return Pre{}; }
    float* out; const bf16_t* H1B;
    __device__ __forceinline__ bool operator()(f32x4 (&acc)[2][2][4][2], const Unit& u, int wr, int wc, int fr, int fq, const Pre&) const {
        const int row0 = u.pm * BM + wr * 64 + fr, col0 = u.pn * BM + wc * 64 + 8 * fq;
#pragma unroll
        for (int ai = 0; ai < 2; ++ai)
#pragma unroll
            for (int m = 0; m < 4; ++m) { const size_t off = (size_t)(row0 + ai * HALF + m * 16) * DM + col0;
#pragma unroll
                for (int bj = 0; bj < 2; ++bj) { const size_t o = off + bj * 32; const u32x4 w = *(const u32x4*)(H1B + o);
                    *(f32x4*)(out + o) = (f32x4){bflo(w.x), bfhi(w.x), bflo(w.y), bfhi(w.y)} + acc[ai][bj][m][0];
                    *(f32x4*)(out + o + 4) = (f32x4){bflo(w.z), bfhi(w.z), bflo(w.w), bfhi(w.w)} + acc[ai][bj][m][1]; }
                if (m & 1) asm volatile("" ::: "memory"); }
        return false;
    }
};

template <class Epi, class Sched>
__device__ __forceinline__ void gemm_phase(PG8_LAS unsigned char* lds, const Gemm g, const Sched& S, const Epi& E) {
    const int tid = opaque_tid(), wid = __builtin_amdgcn_readfirstlane(tid >> 6), lane = tid & 63, wr = wid >> 2, wc = wid & 3, fr = lane & 15, fq = lane >> 4;
    const int nt = g.nt;
    unsigned voffA[2], voffB[2];
#pragma unroll
    for (int i = 0; i < 2; ++i) { int R, C; stage_rc(tid * 16 + i * 8192, R, C); const int Rb = Epi::PERM ? ((R & ~31) + perm32(R & 31)) : R;
        voffA[i] = (unsigned)(R * g.lda + C) * 2u; voffB[i] = (unsigned)(Rb * g.ldb + C) * 2u; }
    const unsigned kstep = (unsigned)(BK * 2);
    const unsigned hstepA = (unsigned)HALF * g.lda * 2, hstepB = (unsigned)HALF * g.ldb * 2;
    const unsigned tstepA = 2 * hstepA, tstepB = 2 * hstepB;
    const __amdgpu_buffer_rsrc_t rsA = __builtin_amdgcn_make_buffer_rsrc((void*)g.A, 0, -1, 0x00020000);
    const __amdgpu_buffer_rsrc_t rsB = __builtin_amdgcn_make_buffer_rsrc((void*)g.Bt, 0, -1, 0x00020000);
    const unsigned ldsw = (unsigned)wid * 1024u;
    const int aoff = lds_byte(wr * 64 + fr, fq * 8), boff = lds_byte(wc * 32 + fr, fq * 8);
#define PG8_SA(b, h) (((b) * 2 + (h)) * HTB)
#define PG8_SB(b, h) ((4 + (b) * 2 + (h)) * HTB)
#define PG8_STAGE(bufoff, rs, soff, voff) do { _Pragma("unroll") for (int _i = 0; _i < 2; ++_i) \
        __builtin_amdgcn_raw_ptr_buffer_load_lds(rs, (PG8_LAS unsigned*)(lds + (bufoff) + ldsw + _i * 8192), 16, (int)(voff)[_i], (int)(soff), 0, 0); } while (0)
#define PG8_LDA(dst, b, h) do { _Pragma("unroll") for (int m = 0; m < 4; ++m) _Pragma("unroll") for (int k = 0; k < 2; ++k) dst[m][k] = *(const PG8_LAS bf16x8*)(lds + PG8_SA(b, h) + aoff + m * 2048 + k * 1024); } while (0)
#define PG8_LDB(dst, b, h) do { _Pragma("unroll") for (int n = 0; n < 2; ++n) _Pragma("unroll") for (int k = 0; k < 2; ++k) dst[n][k] = *(const PG8_LAS bf16x8*)(lds + PG8_SB(b, h) + boff + n * 2048 + k * 1024); } while (0)
#define PG8_MMA(ai, bj, At, Bt) do { __builtin_amdgcn_s_setprio(1); _Pragma("unroll") for (int m = 0; m < 4; ++m) _Pragma("unroll") for (int n = 0; n < 2; ++n) _Pragma("unroll") for (int k = 0; k < 2; ++k) \
        acc[ai][bj][m][n] = __builtin_amdgcn_mfma_f32_16x16x32_bf16(Bt[n][k], At[m][k], acc[ai][bj][m][n], 0, 0, 0); __builtin_amdgcn_s_setprio(0); } while (0)
#define PG8_WAIT_V(n) asm volatile("s_waitcnt vmcnt(" #n ")" ::: "memory")
#define PG8_WAIT_L(n) asm volatile("s_waitcnt lgkmcnt(" #n ")" ::: "memory")
#define PG8_BAR __builtin_amdgcn_s_barrier()
#define PG8_SCHED __builtin_amdgcn_sched_barrier(0)
    Unit cur, nxt; int ui = 0;
    if (!S.next(0, cur)) return;
    f32x4 acc[2][2][4][2];
#pragma unroll
    for (int a = 0; a < 2; ++a)
#pragma unroll
        for (int b = 0; b < 2; ++b)
#pragma unroll
            for (int m = 0; m < 4; ++m)
#pragma unroll
                for (int n = 0; n < 2; ++n) acc[a][b][m][n] = (f32x4){0.f, 0.f, 0.f, 0.f};
    bf16x8 At[4][2], B0[2][2], B1[2][2];
    typename Epi::Pre pre = E.prefetch(cur, wr, wc, fr, fq);
    unsigned cA = (unsigned)cur.pm * tstepA + (unsigned)cur.pass * g.kpass * 2 + (cur.pm >= g.gapFrom ? g.gapA : 0u), cB = (unsigned)cur.pn * tstepB + (unsigned)cur.pass * g.kpass * 2;
    PG8_STAGE(PG8_SB(0, 0), rsB, cB, voffB); PG8_STAGE(PG8_SB(0, 1), rsB, cB + hstepB, voffB); PG8_STAGE(PG8_SA(0, 0), rsA, cA, voffA); PG8_STAGE(PG8_SA(0, 1), rsA, cA + hstepA, voffA);
    if (wr == 1) PG8_BAR;
    PG8_WAIT_V(2); PG8_BAR;
    PG8_STAGE(PG8_SB(1, 0), rsB, cB + kstep, voffB); PG8_STAGE(PG8_SA(1, 0), rsA, cA + kstep, voffA); PG8_STAGE(PG8_SB(1, 1), rsB, cB + hstepB + kstep, voffB);
    PG8_WAIT_V(6); PG8_BAR;
    for (;;) {
        const bool has_next = S.next(ui + 1, nxt);
        const unsigned nA = has_next ? (unsigned)nxt.pm * tstepA + (unsigned)nxt.pass * g.kpass * 2 + (nxt.pm >= g.gapFrom ? g.gapA : 0u) : cA;
        const unsigned nB = has_next ? (unsigned)nxt.pn * tstepB + (unsigned)nxt.pass * g.kpass * 2 : cB;
        for (int t = 0; t < nt; t += 2) {
            const bool last = (t == nt - 2);
            const unsigned a1 = cA + (unsigned)(t + 1) * kstep;
            const unsigned a2 = last ? nA : cA + (unsigned)(t + 2) * kstep, b2 = last ? nB : cB + (unsigned)(t + 2) * kstep;
            const unsigned a3 = a2 + kstep, b3 = b2 + kstep;
            PG8_LDB(B0, 0, 0); PG8_LDB(B1, 0, 1); PG8_SCHED; PG8_LDA(At, 0, 0); PG8_STAGE(PG8_SA(1, 1), rsA, a1 + hstepA, voffA);
            PG8_WAIT_V(8); PG8_WAIT_L(0); PG8_BAR; PG8_MMA(0, 0, At, B0); PG8_MMA(0, 1, At, B1); PG8_BAR; PG8_SCHED;
            PG8_LDA(At, 0, 1); PG8_STAGE(PG8_SB(0, 0), rsB, b2, voffB); PG8_STAGE(PG8_SB(0, 1), rsB, b2 + hstepB, voffB); PG8_STAGE(PG8_SA(0, 0), rsA, a2, voffA);
            PG8_WAIT_V(8); PG8_WAIT_L(0); PG8_BAR; PG8_MMA(1, 0, At, B0); PG8_MMA(1, 1, At, B1); PG8_BAR; PG8_SCHED;
            PG8_LDB(B0, 1, 0); PG8_LDB(B1, 1, 1); PG8_SCHED; PG8_LDA(At, 1, 0); PG8_STAGE(PG8_SA(0, 1), rsA, a2 + hstepA, voffA);
            PG8_WAIT_V(8); PG8_WAIT_L(0); PG8_BAR; PG8_MMA(0, 0, At, B0); PG8_MMA(0, 1, At, B1); PG8_BAR; PG8_SCHED;
            PG8_LDA(At, 1, 1); PG8_STAGE(PG8_SB(1, 0), rsB, b3, voffB); PG8_STAGE(PG8_SB(1, 1), rsB, b3 + hstepB, voffB); PG8_STAGE(PG8_SA(1, 0), rsA, a3, voffA);
            PG8_WAIT_V(8); PG8_WAIT_L(0); PG8_BAR; PG8_MMA(1, 0, At, B0); PG8_MMA(1, 1, At, B1); PG8_BAR; PG8_SCHED;
        }
        if (wr == 0) PG8_BAR;
        const bool keep = E(acc, cur, wr, wc, fr, fq, pre);
        if (has_next) pre = E.prefetch(nxt, wr, wc, fr, fq);
        if (!has_next) break;
        if (!keep) {
#pragma unroll
            for (int a = 0; a < 2; ++a)
#pragma unroll
                for (int b = 0; b < 2; ++b)
#pragma unroll
                    for (int m = 0; m < 4; ++m)
#pragma unroll
                        for (int n = 0; n < 2; ++n) acc[a][b][m][n] = (f32x4){0.f, 0.f, 0.f, 0.f};
        }
        cur = nxt; cA = nA; cB = nB; ++ui;
        if (wr == 1) PG8_BAR;
    }
    PG8_WAIT_V(0);
    PG8_BAR;
#undef PG8_SA
#undef PG8_SB
#undef PG8_STAGE
#undef PG8_LDA
#undef PG8_LDB
#undef PG8_MMA
#undef PG8_WAIT_V
#undef PG8_WAIT_L
#undef PG8_BAR
#undef PG8_SCHED
}
}

namespace att {
#define ATT_LAS __attribute__((address_space(3)))
typedef float f32x16 __attribute__((ext_vector_type(16)));
typedef short s16x4 __attribute__((ext_vector_type(4)));
constexpr float NEG = -1.0e30f;
constexpr float SHIFT = 12.0f;
template <int D> struct Cfg {
    static constexpr int KP = D * 2 + 16;
    static constexpr int VP = (D == 128) ? 320 : 192;
    static constexpr int KBYTES = 64 * KP, VBYTES = 64 * VP, STG = KBYTES + VBYTES;
    static constexpr int NKS = D / 16, NDB = D / 32, NCH = D / 8, PPT = (64 * NCH) / NTHREADS;
};
__device__ __forceinline__ s16x4 vtr(const ATT_LAS unsigned char* p) { return __builtin_bit_cast(s16x4, __builtin_amdgcn_ds_read_tr16_b64_v4i16((ATT_LAS s16x4*)p)); }

template <int D, bool MOBA>
__device__ __forceinline__ void attn_unit(ATT_LAS unsigned char* lds, const Params& p, int b, int hg, int blk) {
    typedef Cfg<D> C;
    const int tid = opaque_tid(), lane = tid & 63, wave = __builtin_amdgcn_readfirstlane(tid >> 6), q = lane & 31, hi = lane >> 5;
    unsigned char* ws = p.ws;
    const int seqbase = b * SEQ;
    const int qpos0 = MOBA ? 256 * blk : 64 * blk;
    const int t = MOBA ? qpos0 + 32 * wave + q : qpos0 + 32 * (wave & 1) + q;
    const int head = MOBA ? hg : 4 * hg + (wave >> 1);
    const size_t row = (size_t)(seqbase + t);
    const bf16_t* Qrow = MOBA ? (const bf16_t*)(ws + WS_QB) + row * 1024 + head * 128 : (const bf16_t*)(ws + WS_QA) + row * 1024 + head * 64;
    const int kvpitch = MOBA ? 1024 : 256;
    const bf16_t* Kp = (MOBA ? (const bf16_t*)(ws + WS_KB) : (const bf16_t*)(ws + WS_KA)) + (size_t)seqbase * kvpitch + hg * D;
    const bf16_t* Vp = (MOBA ? (const bf16_t*)(ws + WS_VB) : (const bf16_t*)(ws + WS_VA)) + (size_t)seqbase * kvpitch + hg * D;
    bf16_t* Orow = (bf16_t*)(ws + WS_XN) + row * 2048 + (MOBA ? 1024 + head * 128 : head * 64);
    const float slope2 = (MOBA ? exp2f(-(float)(head + 1)) : exp2f(-0.5f * (float)(head + 1))) * LOG2E;

    bf16x8 qf[C::NKS];
#pragma unroll
    for (int ks = 0; ks < C::NKS; ++ks) qf[ks] = *(const bf16x8*)(Qrow + 16 * ks + 8 * hi);

    if constexpr (MOBA) {
        float ssq = 0.f;
#pragma unroll
        for (int ks = 0; ks < C::NKS; ++ks) { float f[8]; unpack8(__builtin_bit_cast(u32x4, qf[ks]), f);
#pragma unroll
            for (int j = 0; j < 8; ++j) ssq += f[j] * f[j]; }
        ssq += __shfl_xor(ssq, 32);
        const float rs = rsqrtf(ssq * (1.f / 128.f) + RMS_EPS) * SC_QB;
#pragma unroll
        for (int ks = 0; ks < C::NKS; ++ks) { float f[8]; unpack8(__builtin_bit_cast(u32x4, qf[ks]), f);
            const f32x4 g0 = *(const f32x4*)(p.qnb + 16 * ks + 8 * hi), g1 = *(const f32x4*)(p.qnb + 16 * ks + 8 * hi + 4);
            u32x4 w; w.x = pg8::cvt_pk_bf16(f[0] * rs * g0[0], f[1] * rs * g0[1]); w.y = pg8::cvt_pk_bf16(f[2] * rs * g0[2], f[3] * rs * g0[3]);
            w.z = pg8::cvt_pk_bf16(f[4] * rs * g1[0], f[5] * rs * g1[1]); w.w = pg8::cvt_pk_bf16(f[6] * rs * g1[2], f[7] * rs * g1[3]);
            qf[ks] = __builtin_bit_cast(bf16x8, w); }
    }
    unsigned selbits = 0u;
    if constexpr (MOBA) {
        if (blk > 0) {
            const int* kmean = (const int*)(ws + WS_KMEAN) + (size_t)(b * 8) * 1024 + head * 128 + 8 * hi;
            float gt[8];
#pragma unroll
            for (int n = 0; n < 7; ++n) {
                float g = -INFINITY;
                if (n < blk) {
                    float part = 0.f;
#pragma unroll
                    for (int ks = 0; ks < 8; ++ks) {
                        const int4 k0 = *(const int4*)(kmean + n * 1024 + 16 * ks), k1 = *(const int4*)(kmean + n * 1024 + 16 * ks + 4);
                        const u32x4 qw = __builtin_bit_cast(u32x4, qf[ks]);
                        part += bflo(qw.x) * (float)k0.x + bfhi(qw.x) * (float)k0.y + bflo(qw.y) * (float)k0.z + bfhi(qw.y) * (float)k0.w
                              + bflo(qw.z) * (float)k1.x + bfhi(qw.z) * (float)k1.y + bflo(qw.w) * (float)k1.z + bfhi(qw.w) * (float)k1.w;
                    }
                    g = part + __shfl_xor(part, 32);
                }
                gt[n] = g;
            }
            gt[7] = -INFINITY;
#pragma unroll
            for (int n = 0; n < 7; ++n) {
                int rank = 0;
#pragma unroll
                for (int n2 = 0; n2 < 7; ++n2) if (n2 != n) rank += (n2 < blk && (gt[n2] > gt[n] || (gt[n2] == gt[n] && n2 < n))) ? 1 : 0;
                if (n < blk && rank < 3) selbits |= (1u << n);
            }
        }
    }

    f32x16 O[C::NDB];
#pragma unroll
    for (int db = 0; db < C::NDB; ++db)
#pragma unroll
        for (int r = 0; r < 16; ++r) O[db][r] = 0.f;
    float l = 0.f;

    const int T = MOBA ? 4 * (blk + 1) : (blk >= 2 ? 3 : blk + 1);
#define ATT_KPOS(i) (MOBA ? ((i) < 4 ? 256 * blk + 64 * (i) : 256 * (((i) - 4) >> 2) + 64 * (((i) - 4) & 3)) : qpos0 - 64 * (i))
    u32x4 kreg[C::PPT], vreg[C::PPT];
    const int prow = tid / C::NCH, pch = tid % C::NCH;
    const unsigned goff = (unsigned)(prow * kvpitch + pch * 8) * 2u;
    const int lk = C::KP * prow + 16 * pch, lv = C::KBYTES + C::VP * prow + 16 * pch;
    constexpr int PR = NTHREADS / C::NCH;
#define ATT_LOAD(kp0) do { const char* _kt = (const char*)(Kp + (size_t)(kp0) * kvpitch); const char* _vt = (const char*)(Vp + (size_t)(kp0) * kvpitch); \
        _Pragma("unroll") for (int _i = 0; _i < C::PPT; ++_i) { kreg[_i] = *(const u32x4*)(_kt + (size_t)_i * PR * kvpitch * 2 + goff); vreg[_i] = *(const u32x4*)(_vt + (size_t)_i * PR * kvpitch * 2 + goff); } } while (0)
#define ATT_WRITE(buf) do { _Pragma("unroll") for (int _i = 0; _i < C::PPT; ++_i) { \
        *(ATT_LAS u32x4*)(lds + (buf) * C::STG + lk + _i * PR * C::KP) = kreg[_i]; *(ATT_LAS u32x4*)(lds + (buf) * C::STG + lv + _i * PR * C::VP) = vreg[_i]; } } while (0)
    const int ka = C::KP * q + 16 * hi;
    const int va = C::VP * (4 * hi + ((lane & 15) >> 2)) + 32 * ((lane >> 4) & 1) + 8 * (lane & 3);
    ATT_LOAD(ATT_KPOS(0)); ATT_WRITE(0); if (T > 1) ATT_LOAD(ATT_KPOS(1)); __syncthreads();
    const int TA = MOBA ? 0 : T;
    for (int i = 0; i < TA; ++i) {
        if (i + 1 < T) ATT_WRITE((i + 1) & 1);
        if (i + 2 < T) ATT_LOAD(ATT_KPOS(i + 2));
        const int kp0 = ATT_KPOS(i);
        int klo = 0, khi = 63;
        if constexpr (MOBA) { khi = t - kp0; }
        else { if (i == 0) khi = t - kp0; if (i == 2) klo = t - 127 - kp0; }
        if (khi > 63) khi = 63; if (klo < 0) klo = 0;
        const bool anyvalid = (khi >= klo);
        if (__any(anyvalid)) {
            const float lbase = slope2 * (float)(kp0 + 4 * hi - t) - SHIFT;
#pragma unroll 1
            for (int hf = 0; hf < 2; ++hf) {
                if (!__any(anyvalid && klo <= 32 * hf + 31 && khi >= 32 * hf)) continue;
                const bool allfull = __all(!anyvalid || (klo <= 32 * hf && khi >= 32 * hf + 31));
                const ATT_LAS unsigned char* Kt = lds + (i & 1) * C::STG + hf * 32 * C::KP;
                const ATT_LAS unsigned char* Vt = lds + (i & 1) * C::STG + C::KBYTES + hf * 32 * C::VP;
                const float lb = anyvalid ? lbase + (float)(32 * hf) * slope2 : NEG;
                f32x16 s;
                if (allfull) {
#pragma unroll
                    for (int r = 0; r < 16; ++r) s[r] = __builtin_fmaf(slope2, (float)((r & 3) + 8 * (r >> 2)), lb);
                } else {
#pragma unroll
                    for (int r = 0; r < 16; ++r) { const int ko = 32 * hf + 4 * hi + (r & 3) + 8 * (r >> 2);
                        s[r] = (ko >= klo && ko <= khi) ? __builtin_fmaf(slope2, (float)((r & 3) + 8 * (r >> 2)), lb) : NEG; }
                }
#pragma unroll
                for (int ks = 0; ks < C::NKS; ++ks) s = __builtin_amdgcn_mfma_f32_32x32x16_bf16(*(const ATT_LAS bf16x8*)(Kt + ka + 32 * ks), qf[ks], s, 0, 0, 0);
                float ls0 = 0.f, ls1 = 0.f, ls2 = 0.f, ls3 = 0.f;
#pragma unroll
                for (int r = 0; r < 16; r += 4) { s[r] = __builtin_amdgcn_exp2f(s[r]); s[r + 1] = __builtin_amdgcn_exp2f(s[r + 1]); s[r + 2] = __builtin_amdgcn_exp2f(s[r + 2]); s[r + 3] = __builtin_amdgcn_exp2f(s[r + 3]);
                    ls0 += s[r]; ls1 += s[r + 1]; ls2 += s[r + 2]; ls3 += s[r + 3]; }
                l += (ls0 + ls1) + (ls2 + ls3);
                bf16x8 pf[2];
#pragma unroll
                for (int ss = 0; ss < 2; ++ss) {
                    u32x4 w;
                    w.x = pg8::cvt_pk_bf16(s[8 * ss + 0], s[8 * ss + 1]); w.y = pg8::cvt_pk_bf16(s[8 * ss + 2], s[8 * ss + 3]); w.z = pg8::cvt_pk_bf16(s[8 * ss + 4], s[8 * ss + 5]); w.w = pg8::cvt_pk_bf16(s[8 * ss + 6], s[8 * ss + 7]);
                    pf[ss] = __builtin_bit_cast(bf16x8, w);
                }
#pragma unroll
                for (int db = 0; db < C::NDB; ++db)
#pragma unroll
                    for (int ss = 0; ss < 2; ++ss) {
                        const s16x4 lo = vtr(Vt + va + 64 * db + C::VP * (16 * ss)), hh = vtr(Vt + va + 64 * db + C::VP * (16 * ss + 8));
                        const bf16x8 vf = (bf16x8){lo[0], lo[1], lo[2], lo[3], hh[0], hh[1], hh[2], hh[3]};
                        O[db] = __builtin_amdgcn_mfma_f32_32x32x16_bf16(vf, pf[ss], O[db], 0, 0, 0);
                    }
            }
        }
        __syncthreads();
    }
    if constexpr (MOBA) {
        auto moba_step = [&](const int i, auto own_tag) __attribute__((always_inline)) {
            constexpr bool OWN = decltype(own_tag)::value;

        if (i + 1 < T) ATT_WRITE((i + 1) & 1);
        if (i + 2 < T) ATT_LOAD(ATT_KPOS(i + 2));
        const int kp0 = ATT_KPOS(i);
        const int khi = t - kp0;
        const bool rowsel = OWN ? (khi >= 0) : (((selbits >> ((i - 4) >> 2)) & 1u) != 0u);
        if (__any(rowsel)) {
            const float lbv = rowsel ? slope2 * (float)(kp0 + 4 * hi - t) - SHIFT : NEG;
            const ATT_LAS unsigned char* Kt = lds + (i & 1) * C::STG;
            const ATT_LAS unsigned char* Vt = lds + (i & 1) * C::STG + C::KBYTES;
            f32x16 s0, s1;
#pragma unroll
            for (int r = 0; r < 16; ++r) { const float cr = (float)((r & 3) + 8 * (r >> 2)); s0[r] = __builtin_fmaf(slope2, cr, lbv); s1[r] = __builtin_fmaf(slope2, cr + 32.f, lbv); }
            if constexpr (OWN) {
#pragma unroll
                for (int r = 0; r < 16; ++r) { const int d0 = khi - (4 * hi + (r & 3) + 8 * (r >> 2));
                    s0[r] += __builtin_bit_cast(float, (d0 >> 31) & 0xF149F2CA);
                    s1[r] += __builtin_bit_cast(float, ((d0 - 32) >> 31) & 0xF149F2CA); }
            }
#pragma unroll
            for (int ks = 0; ks < C::NKS; ++ks) s0 = __builtin_amdgcn_mfma_f32_32x32x16_bf16(*(const ATT_LAS bf16x8*)(Kt + ka + 32 * ks), qf[ks], s0, 0, 0, 0);
            __builtin_amdgcn_sched_barrier(0);
            bf16x8 pf0[2], pf1[2];
            {
#pragma unroll
                for (int ks = 0; ks < C::NKS; ++ks) s1 = __builtin_amdgcn_mfma_f32_32x32x16_bf16(*(const ATT_LAS bf16x8*)(Kt + 32 * C::KP + ka + 32 * ks), qf[ks], s1, 0, 0, 0);
                float ls0 = 0.f, ls1 = 0.f, ls2 = 0.f, ls3 = 0.f;
#pragma unroll
                for (int r = 0; r < 16; r += 4) { s0[r] = __builtin_amdgcn_exp2f(s0[r]); s0[r + 1] = __builtin_amdgcn_exp2f(s0[r + 1]); s0[r + 2] = __builtin_amdgcn_exp2f(s0[r + 2]); s0[r + 3] = __builtin_amdgcn_exp2f(s0[r + 3]);
                    ls0 += s0[r]; ls1 += s0[r + 1]; ls2 += s0[r + 2]; ls3 += s0[r + 3]; }
                l += (ls0 + ls1) + (ls2 + ls3);
#pragma unroll
                for (int ss = 0; ss < 2; ++ss) { u32x4 w;
                    w.x = pg8::cvt_pk_bf16(s0[8 * ss + 0], s0[8 * ss + 1]); w.y = pg8::cvt_pk_bf16(s0[8 * ss + 2], s0[8 * ss + 3]); w.z = pg8::cvt_pk_bf16(s0[8 * ss + 4], s0[8 * ss + 5]); w.w = pg8::cvt_pk_bf16(s0[8 * ss + 6], s0[8 * ss + 7]);
                    pf0[ss] = __builtin_bit_cast(bf16x8, w); }
            }
            __builtin_amdgcn_sched_barrier(0);
            {
#pragma unroll
                for (int db = 0; db < C::NDB; ++db)
#pragma unroll
                    for (int ss = 0; ss < 2; ++ss) {
                        const s16x4 lo = vtr(Vt + va + 64 * db + C::VP * (16 * ss)), hh = vtr(Vt + va + 64 * db + C::VP * (16 * ss + 8));
                        const bf16x8 vf = (bf16x8){lo[0], lo[1], lo[2], lo[3], hh[0], hh[1], hh[2], hh[3]};
                        O[db] = __builtin_amdgcn_mfma_f32_32x32x16_bf16(vf, pf0[ss], O[db], 0, 0, 0);
                    }
                float ls0 = 0.f, ls1 = 0.f, ls2 = 0.f, ls3 = 0.f;
#pragma unroll
                for (int r = 0; r < 16; r += 4) { s1[r] = __builtin_amdgcn_exp2f(s1[r]); s1[r + 1] = __builtin_amdgcn_exp2f(s1[r + 1]); s1[r + 2] = __builtin_amdgcn_exp2f(s1[r + 2]); s1[r + 3] = __builtin_amdgcn_exp2f(s1[r + 3]);
                    ls0 += s1[r]; ls1 += s1[r + 1]; ls2 += s1[r + 2]; ls3 += s1[r + 3]; }
                l += (ls0 + ls1) + (ls2 + ls3);
#pragma unroll
                for (int ss = 0; ss < 2; ++ss) { u32x4 w;
                    w.x = pg8::cvt_pk_bf16(s1[8 * ss + 0], s1[8 * ss + 1]); w.y = pg8::cvt_pk_bf16(s1[8 * ss + 2], s1[8 * ss + 3]); w.z = pg8::cvt_pk_bf16(s1[8 * ss + 4], s1[8 * ss + 5]); w.w = pg8::cvt_pk_bf16(s1[8 * ss + 6], s1[8 * ss + 7]);
                    pf1[ss] = __builtin_bit_cast(bf16x8, w); }
            }
            __builtin_amdgcn_sched_barrier(0);
#pragma unroll
            for (int db = 0; db < C::NDB; ++db)
#pragma unroll
                for (int ss = 0; ss < 2; ++ss) {
                    const s16x4 lo = vtr(Vt + 32 * C::VP + va + 64 * db + C::VP * (16 * ss)), hh = vtr(Vt + 32 * C::VP + va + 64 * db + C::VP * (16 * ss + 8));
                    const bf16x8 vf = (bf16x8){lo[0], lo[1], lo[2], lo[3], hh[0], hh[1], hh[2], hh[3]};
                    O[db] = __builtin_amdgcn_mfma_f32_32x32x16_bf16(vf, pf1[ss], O[db], 0, 0, 0);
                }
            __builtin_amdgcn_sched_barrier(0);
        }
        __syncthreads();
            };
        for (int i = 0; i < 4; ++i) moba_step(i, std::true_type{});
        for (int i = 4; i < T; ++i) moba_step(i, std::false_type{});
    }
#undef ATT_KPOS
#undef ATT_LOAD
#undef ATT_WRITE
    float lt = l + __shfl_xor(l, 32);
    if constexpr (!MOBA) lt += __builtin_amdgcn_exp2f(p.sinks[head] * LOG2E - SHIFT);
    const float inv = 1.0f / lt;
    if constexpr (MOBA) {
        constexpr int OP = 272;
        ATT_LAS unsigned char* tb = lds + wave * (32 * OP);
#pragma unroll
        for (int db = 0; db < C::NDB; ++db)
#pragma unroll
            for (int g = 0; g < 4; ++g) {
                u32x2 w; w.x = pg8::cvt_pk_bf16(O[db][4 * g] * inv, O[db][4 * g + 1] * inv); w.y = pg8::cvt_pk_bf16(O[db][4 * g + 2] * inv, O[db][4 * g + 3] * inv);
                *(ATT_LAS u32x2*)(tb + q * OP + (32 * db + 8 * g + 4 * hi) * 2) = w;
            }
        bf16_t* Ow = (bf16_t*)(ws + WS_XN) + (size_t)(seqbase + qpos0 + 32 * wave) * 2048 + 1024 + head * 128 + 8 * (lane & 15);
#pragma unroll
        for (int j = 0; j < 8; ++j) {
            const int r = 4 * j + (lane >> 4);
            const u32x4 o = *(const ATT_LAS u32x4*)(tb + r * OP + 16 * (lane & 15));
            *(u32x4*)(Ow + (size_t)r * 2048) = o;
        }
        __syncthreads();
    } else {
#pragma unroll
        for (int db = 0; db < C::NDB; ++db)
#pragma unroll
            for (int g = 0; g < 4; ++g) {
                u32x2 w; w.x = pg8::cvt_pk_bf16(O[db][4 * g] * inv, O[db][4 * g + 1] * inv); w.y = pg8::cvt_pk_bf16(O[db][4 * g + 2] * inv, O[db][4 * g + 3] * inv);
                *(u32x2*)(Orow + 32 * db + 8 * g + 4 * hi) = w;
            }
    }
}

__device__ __forceinline__ void swa_phase(ATT_LAS unsigned char* lds, const Params& p, int bid, int nblk) {
    typedef Cfg<64> C;
    constexpr int TILE = C::STG, UBUF = 3 * TILE;
    const int tid = opaque_tid(), lane = tid & 63, wave = __builtin_amdgcn_readfirstlane(tid >> 6), q = lane & 31, hi = lane >> 5;
    unsigned char* ws = p.ws;
    const bf16_t *QA = (const bf16_t*)(ws + WS_QA), *KA = (const bf16_t*)(ws + WS_KA), *VA = (const bf16_t*)(ws + WS_VA);
    bf16_t* OAB = (bf16_t*)(ws + WS_XN);
    const int prow = tid >> 3, pch = tid & 7;
    const int lk = C::KP * prow + 16 * pch, lv = C::KBYTES + C::VP * prow + 16 * pch;
    const int ka = C::KP * q + 16 * hi;
    const int va = C::VP * (4 * hi + ((lane & 15) >> 2)) + 32 * ((lane >> 4) & 1) + 8 * (lane & 3);
    u32x4 kreg[3], vreg[3]; bf16x8 qn[C::NKS];
#define SWA_DEC(u, b_, g_, n_) const int _x##n_ = (u) & 7, _i##n_ = (u) >> 3, _bg##n_ = _x##n_ * 4 + (_i##n_ >> 5); const int b_ = _bg##n_ >> 2, g_ = _bg##n_ & 3, n_ = _i##n_ & 31
#define SWA_LOAD(u) do { SWA_DEC(u, b_, g_, n_); \
        const bf16_t* kt = KA + ((size_t)(b_ * SEQ + 64 * n_ + prow)) * 256 + g_ * 64 + pch * 8; const bf16_t* vt = VA + ((size_t)(b_ * SEQ + 64 * n_ + prow)) * 256 + g_ * 64 + pch * 8; \
        _Pragma("unroll") for (int _i = 0; _i < 3; ++_i) if (_i <= n_) { kreg[_i] = *(const u32x4*)(kt - (size_t)_i * 64 * 256); vreg[_i] = *(const u32x4*)(vt - (size_t)_i * 64 * 256); } \
        const bf16_t* qr = QA + ((size_t)(b_ * SEQ + 64 * n_ + 32 * (wave & 1) + q)) * 1024 + (4 * g_ + (wave >> 1)) * 64; \
        _Pragma("unroll") for (int ks = 0; ks < C::NKS; ++ks) qn[ks] = *(const bf16x8*)(qr + 16 * ks + 8 * hi); } while (0)
#define SWA_WRITE(u, buf) do { SWA_DEC(u, b_, g_, n_); (void)b_; (void)g_; \
        _Pragma("unroll") for (int _i = 0; _i < 3; ++_i) if (_i <= n_) { *(ATT_LAS u32x4*)(lds + (buf) * UBUF + _i * TILE + lk) = kreg[_i]; *(ATT_LAS u32x4*)(lds + (buf) * UBUF + _i * TILE + lv) = vreg[_i]; } } while (0)
    if (bid >= 1024) return;
    SWA_LOAD(bid); SWA_WRITE(bid, 0); __syncthreads();
    int j = 0;
    for (int u = bid; u < 1024; u += nblk, ++j) {
        bf16x8 qf[C::NKS];
#pragma unroll
        for (int ks = 0; ks < C::NKS; ++ks) qf[ks] = qn[ks];
        const int un = u + nblk; const bool more = un < 1024;
        if (more) SWA_LOAD(un);
        SWA_DEC(u, b, g, n);
        const int head = 4 * g + (wave >> 1), qpos0 = 64 * n, t = qpos0 + 32 * (wave & 1) + q;
        const float slope2 = exp2f(-0.5f * (float)(head + 1)) * LOG2E;
        f32x16 O[C::NDB];
#pragma unroll
        for (int db = 0; db < C::NDB; ++db)
#pragma unroll
            for (int r = 0; r < 16; ++r) O[db][r] = 0.f;
        float l = 0.f;
        const int sgn = wave & 1;
        const ATT_LAS unsigned char* ub = lds + (j & 1) * UBUF;
#define SWA_HALF(J, GUARD) do { if (!(GUARD) || (J) <= 2 * n + sgn) { \
            const int g_ = 1 - sgn + (J); \
            const ATT_LAS unsigned char* Kt = ub + (g_ >> 1) * TILE + (1 - (g_ & 1)) * 32 * C::KP; \
            const ATT_LAS unsigned char* Vt = ub + (g_ >> 1) * TILE + C::KBYTES + (1 - (g_ & 1)) * 32 * C::VP; \
            const float lb = slope2 * (float)(4 * hi - 32 * (J) - q) - SHIFT; \
            f32x16 s; \
            _Pragma("unroll") for (int r = 0; r < 16; ++r) { const int ko = 4 * hi + (r & 3) + 8 * (r >> 2); const float v = __builtin_fmaf(slope2, (float)((r & 3) + 8 * (r >> 2)), lb); \
                s[r] = ((J) == 0) ? (ko <= q ? v : NEG) : ((J) == 4) ? (ko >= q + 1 ? v : NEG) : v; } \
            _Pragma("unroll") for (int ks = 0; ks < C::NKS; ++ks) s = __builtin_amdgcn_mfma_f32_32x32x16_bf16(*(const ATT_LAS bf16x8*)(Kt + ka + 32 * ks), qf[ks], s, 0, 0, 0); \
            float ls0 = 0.f, ls1 = 0.f, ls2 = 0.f, ls3 = 0.f; \
            _Pragma("unroll") for (int r = 0; r < 16; r += 4) { s[r] = __builtin_amdgcn_exp2f(s[r]); s[r + 1] = __builtin_amdgcn_exp2f(s[r + 1]); s[r + 2] = __builtin_amdgcn_exp2f(s[r + 2]); s[r + 3] = __builtin_amdgcn_exp2f(s[r + 3]); \
                ls0 += s[r]; ls1 += s[r + 1]; ls2 += s[r + 2]; ls3 += s[r + 3]; } \
            l += (ls0 + ls1) + (ls2 + ls3); \
            bf16x8 pf[2]; \
            _Pragma("unroll") for (int ss = 0; ss < 2; ++ss) { u32x4 w; \
                w.x = pg8::cvt_pk_bf16(s[8 * ss + 0], s[8 * ss + 1]); w.y = pg8::cvt_pk_bf16(s[8 * ss + 2], s[8 * ss + 3]); w.z = pg8::cvt_pk_bf16(s[8 * ss + 4], s[8 * ss + 5]); w.w = pg8::cvt_pk_bf16(s[8 * ss + 6], s[8 * ss + 7]); \
                pf[ss] = __builtin_bit_cast(bf16x8, w); } \
            _Pragma("unroll") for (int db = 0; db < C::NDB; ++db) _Pragma("unroll") for (int ss = 0; ss < 2; ++ss) { \
                const s16x4 lo = vtr(Vt + va + 64 * db + C::VP * (16 * ss)), hh = vtr(Vt + va + 64 * db + C::VP * (16 * ss + 8)); \
                const bf16x8 vf = (bf16x8){lo[0], lo[1], lo[2], lo[3], hh[0], hh[1], hh[2], hh[3]}; \
                O[db] = __builtin_amdgcn_mfma_f32_32x32x16_bf16(vf, pf[ss], O[db], 0, 0, 0); } } } while (0)
        if (n >= 2) { SWA_HALF(0, false); SWA_HALF(1, false); SWA_HALF(2, false); SWA_HALF(3, false); SWA_HALF(4, false); }
        else        { SWA_HALF(0, true);  SWA_HALF(1, true);  SWA_HALF(2, true);  SWA_HALF(3, true);  SWA_HALF(4, true); }
#undef SWA_HALF
        const float lt = l + __shfl_xor(l, 32) + __builtin_amdgcn_exp2f(p.sinks[head] * LOG2E - SHIFT);
        const float inv = 1.0f / lt;
        bf16_t* Orow = OAB + (size_t)(b * SEQ + t) * 2048 + head * 64;
#pragma unroll
        for (int db = 0; db < C::NDB; ++db)
#pragma unroll
            for (int gq = 0; gq < 4; ++gq) {
                u32x2 w; w.x = pg8::cvt_pk_bf16(O[db][4 * gq] * inv, O[db][4 * gq + 1] * inv); w.y = pg8::cvt_pk_bf16(O[db][4 * gq + 2] * inv, O[db][4 * gq + 3] * inv);
                *(u32x2*)(Orow + 32 * db + 8 * gq + 4 * hi) = w;
            }
        if (more) SWA_WRITE(un, (j + 1) & 1);
        __syncthreads();
    }
#undef SWA_DEC
#undef SWA_LOAD
#undef SWA_WRITE
}

__device__ __forceinline__ void attn_phase(ATT_LAS unsigned char* lds, const Params& p, int bid, int nblk) {
    for (int uu = 0;; ++uu) {
        const int it = bid + (uu >> 1) * nblk; if (it >= 256) break;
        const int x = it & 7, idx = it >> 3, bh = x * 8 + (idx >> 2), s = idx & 3;
        attn_unit<128, true>(lds, p, bh >> 3, bh & 7, (uu & 1) ? 7 - s : s);
    }
    __syncthreads();
    swa_phase(lds, p, bid, nblk);
}
}

#define XB_TMO      128
#define XB_XCNT(j)  (256  + 64 * (j))
#define XB_XSUB(j)  (1280 + 64 * (j))
#define XB_XGEN(j)  (2304 + 64 * (j))
#define XB_TOP      3328
#define XB_TOPGEN   3392
#define XCD_BAR_WORDS 3456
#define XB_SPIN_CAP (1u << 18)
#define XLAS __attribute__((address_space(3)))
__device__ __forceinline__ unsigned xb_ld(unsigned* p)              { return __hip_atomic_load(p, __ATOMIC_RELAXED, __HIP_MEMORY_SCOPE_AGENT); }
__device__ __forceinline__ unsigned xb_add(unsigned* p, unsigned v) { return __hip_atomic_fetch_add(p, v, __ATOMIC_RELAXED, __HIP_MEMORY_SCOPE_AGENT); }
__device__ __forceinline__ unsigned xb_xcc_id() { return (unsigned)__builtin_amdgcn_s_getreg((3 << 11) | 20) & 0xFu; }
#define XB_SPIN(cond, bar) do { unsigned _sp = 0; while (cond) { __builtin_amdgcn_s_sleep(1); \
    if ((++_sp & 255u) == 0u) { if (xb_ld(&(bar)[XB_TMO])) break; if (_sp > XB_SPIN_CAP) { atomicAdd(&(bar)[XB_TMO], 1u); break; } } } } while (0)
struct XcdBarrier { unsigned* bar; unsigned x; volatile XLAS unsigned* st; };
__device__ __forceinline__ XcdBarrier xcd_barrier_post(unsigned* bar, volatile XLAS unsigned* st) {
    XcdBarrier b; b.bar = bar; b.x = xb_xcc_id(); b.st = st;
    if (threadIdx.x == 0) (void)xb_add(&bar[XB_XCNT(b.x)], 1u);
    return b;
}
__device__ __forceinline__ void xcd_barrier_complete(unsigned* bar, unsigned x, unsigned& nloc, unsigned& nx) {
    const unsigned G = gridDim.x * gridDim.y * gridDim.z;
    unsigned sum, cnt, mine, sp = 0u;
    for (;;) {
        sum = 0u; cnt = 0u; mine = 0u;
#pragma unroll
        for (unsigned j = 0; j < 16; ++j) { const unsigned c = xb_ld(&bar[XB_XCNT(j)]); sum += c; cnt += (c > 0u) ? 1u : 0u; mine = (j == x) ? c : mine; }
        if (sum == G) break;
        __builtin_amdgcn_s_sleep(1);
        if ((++sp & 255u) == 0u) { if (xb_ld(&bar[XB_TMO])) break; if (sp > XB_SPIN_CAP) { atomicAdd(&bar[XB_TMO], 1u); break; } }
    }
    nloc = mine > 0u ? mine : 1u; nx = cnt > 0u ? cnt : 1u;
}
__device__ __forceinline__ void xcd_barrier(const XcdBarrier& b) {
    asm volatile("s_waitcnt vmcnt(0)" ::: "memory");
    __syncthreads();
    if (threadIdx.x == 0) {
        unsigned* bar = b.bar;
        __builtin_amdgcn_s_waitcnt(0);
        unsigned nloc = b.st[0], nx = b.st[1];
        if (nloc == 0u) { xcd_barrier_complete(bar, b.x, nloc, nx); b.st[0] = nloc; b.st[1] = nx; }
        const unsigned old = xb_add(&bar[XB_XSUB(b.x)], 1u);
        const unsigned gen = old / nloc;
        if (old + 1u == (gen + 1u) * nloc) {
            __builtin_amdgcn_fence(__ATOMIC_RELEASE, "agent");
            asm volatile("s_waitcnt vmcnt(0)" ::: "memory");
            const unsigned og = xb_add(&bar[XB_TOP], 1u);
            const unsigned tg = og / nx;
            if (og + 1u == (tg + 1u) * nx) xb_add(&bar[XB_TOPGEN], 1u);
            else XB_SPIN(xb_ld(&bar[XB_TOPGEN]) == tg, bar);
            __builtin_amdgcn_fence(__ATOMIC_ACQUIRE, "agent");
            xb_add(&bar[XB_XGEN(b.x)], 1u);
            asm volatile("s_waitcnt vmcnt(0)" ::: "memory");
        } else {
            XB_SPIN(xb_ld(&bar[XB_XGEN(b.x)]) == gen, bar);
            __builtin_amdgcn_fence(__ATOMIC_ACQUIRE, "agent");
            asm volatile("s_waitcnt vmcnt(0)" ::: "memory");
        }
    }
    __syncthreads();
}

constexpr int LDS_BYTES = 147456, MISC_OFF = 131072 + 320, XCH_OFF = 131072 + 1024;
#define GRID_SYNC() xcd_barrier(xbar)
#define XB_CLUSTER(k) (4096 + 64 * (k))
#define XB_WREADY  XB_CLUSTER(72)
#define XB_ATTDONE XB_CLUSTER(73)
__device__ __forceinline__ void cluster_barrier(unsigned* bar, int k, unsigned target, bool same_l2, int also_arrive = 0, int wait2 = 0, unsigned target2 = 0u) {
    asm volatile("s_waitcnt vmcnt(0)" ::: "memory");
    __syncthreads();
    if (threadIdx.x == 0) {
        if (!same_l2) __builtin_amdgcn_fence(__ATOMIC_RELEASE, "agent");
        asm volatile("s_waitcnt vmcnt(0)" ::: "memory");
        if (also_arrive) (void)xb_add(&bar[also_arrive], 1u);
        (void)xb_add(&bar[XB_CLUSTER(k)], 1u);
        XB_SPIN(xb_ld(&bar[XB_CLUSTER(k)]) < target, bar);
        if (wait2) XB_SPIN(xb_ld(&bar[wait2]) < target2, bar);
        __builtin_amdgcn_fence(__ATOMIC_ACQUIRE, "agent");
        asm volatile("s_waitcnt vmcnt(0)" ::: "memory");
    }
    __syncthreads();
}
#ifndef P1_LAG_TICKS
#define P1_LAG_TICKS 1200
#endif
#ifndef PROBE_P0
#define PROBE_P0 1
#endif
#ifndef PROBE_P1
#define PROBE_P1 1
#endif
#ifndef PROBE_P15
#define PROBE_P15 1
#endif
#ifndef PROBE_ATT
#define PROBE_ATT 1
#endif
#ifndef PROBE_P3
#define PROBE_P3 1
#endif
#ifndef PROBE_P5
#define PROBE_P5 1
#endif
__global__ void __launch_bounds__(NTHREADS, 2) fwd_megakernel(Params p) {
    extern __shared__ __attribute__((aligned(16))) unsigned char lds[];
    const int bid = blockIdx.x, nblk = gridDim.x;
    unsigned char* ws = p.ws;
    PG8_LAS unsigned char* ring = (PG8_LAS unsigned char*)lds;
    volatile XLAS unsigned* misc = (volatile XLAS unsigned*)((XLAS unsigned char*)lds + MISC_OFF);
    if (threadIdx.x < 8) misc[threadIdx.x] = 0u;
    __syncthreads();
    const XcdBarrier xbar = xcd_barrier_post((unsigned*)(ws + WS_CTL), misc);
    const bool clustered = (nblk == 256); const int cluster = 8 * (bid & 7) + ((bid >> 3) & 7); const unsigned csize = 4u;
    if (threadIdx.x == 0) __hip_atomic_store((unsigned*)(ws + WS_CTL) + 16384 + bid, xbar.x, __ATOMIC_RELAXED, __HIP_MEMORY_SCOPE_AGENT);
    bool same_l2 = false, same_l2_group = false;
#define GROUP_SYNC(n) do { if (clustered) cluster_barrier((unsigned*)(ws + WS_CTL), 64 + (bid & 7), (unsigned)(n) * 32u, same_l2_group); else GRID_SYNC(); } while (0)
#define SEAM_SYNC(n) do { if (clustered) cluster_barrier((unsigned*)(ws + WS_CTL), cluster, (unsigned)(n) * csize, same_l2); else GRID_SYNC(); } while (0)
    const int n9 = (M / 256) * (NIN / 256) - 8 * nblk; const bool defer_late = (nblk == 256);
    { p0_prologue(p, defer_late, bid, nblk, (P0_LAS unsigned char*)lds); GRID_SYNC(); }
    if (clustered) {
        const unsigned* ids = (const unsigned*)(ws + WS_CTL) + 16384; const int b0 = (bid & 7) + 8 * ((bid >> 3) & 7);
        const unsigned i0 = xb_ld((unsigned*)ids + b0), i1 = xb_ld((unsigned*)ids + b0 + 64), i2 = xb_ld((unsigned*)ids + b0 + 128), i3 = xb_ld((unsigned*)ids + b0 + 192);
        same_l2 = (i0 == i1) && (i1 == i2) && (i2 == i3);
        bool g = true;
        for (int j = 0; j < 32; ++j) g = g && (xb_ld((unsigned*)ids + (bid & 7) + 8 * j) == i0);
        same_l2_group = g;
    }
#if PROBE_P0 > 1
    { p0_prologue(p, defer_late, bid, nblk, (P0_LAS unsigned char*)lds); GRID_SYNC(); }
#endif

    {
        if (defer_late && bid >= n9) { const int lw = (bid - n9) * NWAVES + (threadIdx.x >> 6), LNW = (nblk - n9) * NWAVES;
            p0_weights<1>(p, lw, LNW, (P0_LAS unsigned char*)lds); p0_weights<2>(p, lw, LNW, (P0_LAS unsigned char*)lds);
            asm volatile("s_waitcnt vmcnt(0)" ::: "memory"); __syncthreads();
            if (clustered && threadIdx.x == 0) {
                __builtin_amdgcn_fence(__ATOMIC_RELEASE, "agent"); asm volatile("s_waitcnt vmcnt(0)" ::: "memory");
                (void)xb_add((unsigned*)(ws + WS_CTL) + XB_WREADY, 1u); } }
        pg8::Gemm g{(const bf16_t*)(ws + WS_XN), (const bf16_t*)(ws + WS_WIN), 2048, 2048, 32, 0}; pg8::TileOrder<1> S; S.init(M, NIN, nblk, bid);
        pg8::EpiZ E{ws, p.b_gate, p.qna, p.kna, p.knb, (PG8_LAS float*)((PG8_LAS unsigned char*)lds + XCH_OFF)}; pg8::gemm_phase(ring, g, S, E); GROUP_SYNC(1); }
#if PROBE_P1 > 1
    {
        pg8::Gemm g{(const bf16_t*)(ws + WS_XN), (const bf16_t*)(ws + WS_WIN), 2048, 2048, 32, 0}; pg8::TileOrder<1> S; S.init(M, NIN, nblk, bid);
        pg8::EpiZ E{ws, p.b_gate, p.qna, p.kna, p.knb, (PG8_LAS float*)((PG8_LAS unsigned char*)lds + XCH_OFF)}; pg8::gemm_phase(ring, g, S, E); GRID_SYNC(); }
#endif

    { att::attn_phase((ATT_LAS unsigned char*)lds, p, bid, nblk);
      if (clustered) cluster_barrier((unsigned*)(ws + WS_CTL), 64 + (bid & 7), 2u * 32u, same_l2_group, XB_ATTDONE, XB_WREADY, (unsigned)(nblk - n9)); else GRID_SYNC(); }
#if PROBE_ATT > 1
    { att::attn_phase((ATT_LAS unsigned char*)lds, p, bid, nblk); GRID_SYNC(); }
#endif

    {
        pg8::Gemm g{(const bf16_t*)(ws + WS_XN), (const bf16_t*)(ws + WS_WAB), 2048, 2048, 16, 1024}; pg8::TileOrder<2> S; S.init(M, DM, nblk, bid);
        pg8::EpiMixed E{(const bf16_t*)(ws + WS_GATES), (bf16_t*)(ws + WS_MIXED)}; pg8::gemm_phase(ring, g, S, E); SEAM_SYNC(1); }

    { pg8::Gemm g{(const bf16_t*)(ws + WS_MIXED), (const bf16_t*)(ws + WS_WO), 4096, 2048, 32, 0}; pg8::TileOrder<1> S; S.init(M, DM, nblk, bid);
      pg8::EpiWo E{p.x, p.out, (bf16_t*)(ws + WS_XN), (float*)(ws + WS_SUMSQ)}; pg8::gemm_phase(ring, g, S, E); }
    if (clustered) cluster_barrier((unsigned*)(ws + WS_CTL), cluster, 2u * csize, same_l2, 0, XB_ATTDONE, (unsigned)nblk); else GRID_SYNC();
    {
        pg8::Gemm g{(const bf16_t*)(ws + WS_XN), (const bf16_t*)(ws + WS_WGU), 2048, 2048, 32, 0}; pg8::TileOrder<1> S; S.init(M, 2 * DFF, nblk, bid);
        pg8::EpiSwiglu E{(const float*)(ws + WS_SUMSQ), (bf16_t*)(ws + WS_ACT)}; pg8::gemm_phase(ring, g, S, E); SEAM_SYNC(3); }

    { pg8::Gemm g{(const bf16_t*)(ws + WS_ACT), (const bf16_t*)(ws + WS_WD), DFF, DFF, DFF / 64, 0, (unsigned)ACT_GAP, ACT_GAP_FROM}; pg8::TileOrder<1> S; S.init(M, DM, nblk, bid);
      pg8::EpiDown E{p.out, (const bf16_t*)(ws + WS_XN)}; pg8::gemm_phase(ring, g, S, E); }
}

extern "C" void kernel_launch(void* const* d_in, const int* in_sizes, int n_in, void* d_out, int out_size, void* d_ws, size_t ws_size, hipStream_t stream) {
    if (n_in != 16 || ws_size < WS_END) { fprintf(stderr, "kernel_launch: unexpected n_in %d / ws_size %zu\n", n_in, ws_size); return; }
    static int grid_blocks = 0;
    if (!grid_blocks) {
        int dev = 0, cus = 0, per_cu = 0;
        (void)hipGetDevice(&dev);
        (void)hipDeviceGetAttribute(&cus, hipDeviceAttributeMultiprocessorCount, dev);
        (void)hipFuncSetAttribute((const void*)fwd_megakernel, hipFuncAttributeMaxDynamicSharedMemorySize, LDS_BYTES);
        (void)hipOccupancyMaxActiveBlocksPerMultiprocessor(&per_cu, (const void*)fwd_megakernel, NTHREADS, LDS_BYTES);
        if (per_cu < 1) per_cu = 1;
        grid_blocks = cus * per_cu;
        fprintf(stderr, "kernel_launch: cus %d per_cu %d grid %d\n", cus, per_cu, grid_blocks);
    }
    Params p{};
    p.x = (const float*)d_in[0]; p.norm1_g = (const float*)d_in[1]; p.w_in = (const float*)d_in[2]; p.b_gate = (const float*)d_in[3];
    p.qna = (const float*)d_in[4]; p.kna = (const float*)d_in[5]; p.sinks = (const float*)d_in[6]; p.qnb = (const float*)d_in[7]; p.knb = (const float*)d_in[8];
    p.wba = (const float*)d_in[9]; p.wbb = (const float*)d_in[10]; p.wo = (const float*)d_in[11]; p.norm2_g = (const float*)d_in[12];
    p.wg = (const float*)d_in[13]; p.wu = (const float*)d_in[14]; p.wd = (const float*)d_in[15];
    p.out = (float*)d_out; p.ws = (unsigned char*)d_ws;
    (void)hipMemsetAsync((char*)d_ws + WS_CTL, 0, 65536, stream);
    void* args[] = {&p};
    hipError_t e = hipLaunchCooperativeKernel((const void*)fwd_megakernel, dim3(grid_blocks), dim3(NTHREADS), args, LDS_BYTES, stream);
    if (e != hipSuccess) fprintf(stderr, "cooperative launch failed: %s (grid %d)\n", hipGetErrorString(e), grid_blocks);
}
```
